# Optimizing an MI355X kernel written in HIP

```python
import jax, jax.numpy as jnp
from jax import lax
import numpy as np

D_MODEL = 1024
BATCH = 4
SEQ = 4096
DEPTH = 2

GRID_W = 64
CTX_LEN = 256
NORM_EPS = 1e-6
NEG_INF = -1e30
MIX_W = D_MODEL // 2
N_BRANCH = 3
GLA_HEADS = 4
GLA_DV = MIX_W // GLA_HEADS
GLA_DK = GLA_DV // 2
GLA_GATE_RANK = 16
GLA_GATE_NORM = 16.0
GLA_CHUNK = 64
SWA_HEAD_DIM = 64
SWA_Q_HEADS = MIX_W // SWA_HEAD_DIM
SWA_KV_HEADS = SWA_Q_HEADS // 4
SWA_GROUP = SWA_Q_HEADS // SWA_KV_HEADS
SWA_WINDOW = 128
SWA_BLOCK = 128
ROPE_FREQS = SWA_HEAD_DIM // 4
ROPE_BASE = 10000.0
RWKV_HEAD = 64
RWKV_HEADS = MIX_W // RWKV_HEAD
RWKV_DECAY_RANK = 64
RWKV_A_RANK = 64
RWKV_GATE_RANK = 128
RWKV_GN_EPS = 64e-5
FFN_HIDDEN = -(-8 * D_MODEL // (3 * 256)) * 256
GLA_SPLIT = (GLA_HEADS * GLA_DK, GLA_HEADS * GLA_DK, MIX_W, GLA_GATE_RANK, GLA_GATE_RANK, MIX_W)
SWA_SPLIT = (SWA_Q_HEADS * SWA_HEAD_DIM, SWA_KV_HEADS * SWA_HEAD_DIM, SWA_KV_HEADS * SWA_HEAD_DIM)
RWKV_SPLIT = (MIX_W, MIX_W, MIX_W, RWKV_DECAY_RANK, RWKV_A_RANK, RWKV_GATE_RANK)
GROUP_SPLIT = (sum(GLA_SPLIT), sum(SWA_SPLIT), sum(RWKV_SPLIT), N_BRANCH * D_MODEL)
IN_WIDTH = sum(GROUP_SPLIT)

kernel_name = 'hybrid_gla_swa_rwkv7_dit_block'


def rmsnorm(x, g):
    x32 = x.astype(jnp.float32)
    y = x32 * lax.rsqrt(jnp.mean(x32 * x32, axis=-1, keepdims=True) + NORM_EPS)
    return (y * g.astype(jnp.float32)).astype(x.dtype)


def modulate(h, shift, scale):
    return h * (1 + scale[:, None]) + shift[:, None]


def swiglu(h, w1, w3, w2):
    return (jax.nn.silu(h @ w1) * (h @ w3)) @ w2


def split_cols(a, widths):
    return jnp.split(a, np.cumsum(widths)[:-1].tolist(), axis=-1)


def flip(a):
    return a[:, ::-1]


def centred_shift(f):
    z = jnp.zeros_like(f[:, :1])
    return 0.5 * (jnp.concatenate([z, f[:, :-1]], axis=1) + jnp.concatenate([f[:, 1:], z], axis=1))


def axial_rope(T):
    rows = T // GRID_W
    row = jnp.repeat(jnp.arange(rows), GRID_W).astype(jnp.float32)
    col = jnp.tile(jnp.arange(GRID_W), rows).astype(jnp.float32)
    inv = ROPE_BASE ** (-jnp.arange(ROPE_FREQS, dtype=jnp.float32) / ROPE_FREQS)
    ang = jnp.stack([row[:, None] * inv, col[:, None] * inv], axis=1)
    return jnp.cos(ang), jnp.sin(ang)


def apply_rope(x, cos, sin):
    B, T, H, Dh = x.shape
    xs = x.reshape(B, T, H, 2, 2, ROPE_FREQS)
    x1, x2 = xs[..., 0, :], xs[..., 1, :]
    cs, sn = cos[None, :, None].astype(x.dtype), sin[None, :, None].astype(x.dtype)
    return jnp.stack([x1 * cs - x2 * sn, x2 * cs + x1 * sn], axis=-2).reshape(B, T, H, Dh)


def gla_features(p, w_gk2, b_gk):
    q, k, v, gkf, gkb, og = split_cols(p, GLA_SPLIT)
    B, T, _ = q.shape
    heads_k = lambda t: t.reshape(B, T, GLA_HEADS, GLA_DK)
    log_gate = lambda lr, d: heads_k(jax.nn.log_sigmoid((lr @ w_gk2[d] + b_gk[d]).astype(jnp.float32)) / GLA_GATE_NORM)
    return (heads_k(q) * GLA_DK ** -0.5, heads_k(k), v.reshape(B, T, GLA_HEADS, GLA_DV),
            log_gate(gkf, 0), log_gate(gkb, 1), og)


def gla_scan(q, k, v, log_g, s0, with_out):
    B, T, H, K = k.shape
    V = v.shape[-1]
    n = T // GLA_CHUNK
    chunks = lambda a: a.astype(jnp.float32).reshape(B, n, GLA_CHUNK, H, a.shape[-1]).transpose(1, 0, 3, 2, 4)
    lower = jnp.tril(jnp.ones((GLA_CHUNK, GLA_CHUNK), bool))[:, :, None]
    xs = (chunks(k), chunks(v), chunks(log_g)) + ((chunks(q),) if with_out else ())

    def step(s, inp):
        kc, vc, gc = inp[:3]
        b = jnp.cumsum(gc, axis=2)
        b_last = b[:, :, -1:]
        s_new = jnp.exp(b_last[:, :, 0])[..., None] * s + jnp.einsum('bhck,bhcv->bhkv', kc * jnp.exp(b_last - b), vc)
        if not with_out:
            return s_new, None
        qc = inp[3]
        o_inter = jnp.einsum('bhck,bhkv->bhcv', qc * jnp.exp(b), s)
        rel = jnp.exp(jnp.where(lower, b[:, :, :, None] - b[:, :, None], -jnp.inf))
        att = jnp.einsum('bhik,bhjk,bhijk->bhij', qc, kc, rel)
        return s_new, o_inter + jnp.einsum('bhij,bhjv->bhiv', att, vc)

    s_fin, o = lax.scan(step, s0, xs)
    if not with_out:
        return s_fin, None
    return s_fin, o.transpose(1, 0, 3, 2, 4).reshape(B, T, H, V)


def gla_out(o, og, g_gla):
    B, T, H, V = o.shape
    return (rmsnorm(o, g_gla).reshape(B, T, H * V) * jax.nn.silu(og.astype(jnp.float32))).astype(og.dtype)


def gla_branch(fz, fx, g_gla, need_ctx):
    qz, kz, vz, lfz, lbz, ogz = fz
    qx, kx, vx, lfx, lbx, ogx = fx
    s0 = jnp.zeros((kx.shape[0], GLA_HEADS, GLA_DK, GLA_DV), jnp.float32)
    sf, ozf = gla_scan(qz, kz, vz, lfz, s0, need_ctx)
    sb, ozb = gla_scan(flip(qz), flip(kz), flip(vz), flip(lbz), s0, need_ctx)
    _, oxf = gla_scan(qx, kx, vx, lfx, sf, True)
    _, oxb = gla_scan(flip(qx), flip(kx), flip(vx), flip(lbx), sb, True)
    yx = gla_out(oxf + flip(oxb), ogx, g_gla)
    yz = gla_out(ozf + flip(ozb), ogz, g_gla) if need_ctx else None
    return yz, yx


def swa_features(p):
    q, k, v = split_cols(p, SWA_SPLIT)
    B, T, _ = q.shape
    return (q.reshape(B, T, SWA_Q_HEADS, SWA_HEAD_DIM), k.reshape(B, T, SWA_KV_HEADS, SWA_HEAD_DIM),
            v.reshape(B, T, SWA_KV_HEADS, SWA_HEAD_DIM))


def windowed_attention(q, k, v, k_ctx, v_ctx, sink):
    B, T, Hq, Dh = q.shape
    nb = T // SWA_BLOCK
    qb = q.reshape(B, nb, SWA_BLOCK, SWA_KV_HEADS, SWA_GROUP, Dh) * Dh ** -0.5

    def neighbours(a):
        ab = jnp.pad(a, ((0, 0), (SWA_BLOCK, SWA_BLOCK), (0, 0), (0, 0))).reshape(B, nb + 2, SWA_BLOCK, SWA_KV_HEADS, Dh)
        return jnp.concatenate([ab[:, :-2], ab[:, 1:-1], ab[:, 2:]], axis=2)

    kw, vw = neighbours(k), neighbours(v)
    s_loc = jnp.einsum('bnqhgd,bnkhd->bhgnqk', qb, kw).astype(jnp.float32)
    s_ctx = jnp.einsum('bnqhgd,bchd->bhgnqc', qb, k_ctx).astype(jnp.float32)
    blk = jnp.arange(nb)[:, None]
    qpos = (blk * SWA_BLOCK + jnp.arange(SWA_BLOCK)[None, :])[:, :, None]
    kpos = ((blk - 1) * SWA_BLOCK + jnp.arange(3 * SWA_BLOCK)[None, :])[:, None, :]
    band = (jnp.abs(kpos - qpos) <= SWA_WINDOW) & (kpos >= 0) & (kpos < T)
    sink_b = jnp.broadcast_to(sink.astype(jnp.float32).reshape(1, SWA_KV_HEADS, SWA_GROUP, 1, 1, 1), s_loc.shape[:-1] + (1,))
    p = jax.nn.softmax(jnp.concatenate([jnp.where(band, s_loc, NEG_INF), s_ctx, sink_b], axis=-1), axis=-1)
    p_loc = p[..., :3 * SWA_BLOCK].astype(v.dtype)
    p_ctx = p[..., 3 * SWA_BLOCK:-1].astype(v.dtype)
    out = jnp.einsum('bhgnqk,bnkhd->bnqhgd', p_loc, vw) + jnp.einsum('bhgnqc,bchd->bnqhgd', p_ctx, v_ctx)
    return out.reshape(B, T, Hq * Dh)


def context_attention(q, k, v, sink):
    B, C, Hq, Dh = q.shape
    qg = q.reshape(B, C, SWA_KV_HEADS, SWA_GROUP, Dh) * Dh ** -0.5
    s = jnp.einsum('bqhgd,bkhd->bhgqk', qg, k).astype(jnp.float32)
    sink_b = jnp.broadcast_to(sink.astype(jnp.float32).reshape(1, SWA_KV_HEADS, SWA_GROUP, 1, 1), s.shape[:-1] + (1,))
    p = jax.nn.softmax(jnp.concatenate([s, sink_b], axis=-1), axis=-1)[..., :-1].astype(v.dtype)
    return jnp.einsum('bhgqk,bkhd->bqhgd', p, v).reshape(B, C, Hq * Dh)


def rwkv_features(p, mu_shift, w0, w_w2, a0, w_a2, w_g2, k_k, k_a):
    p = p + mu_shift * (centred_shift(p) - p)
    r, k, v, wl, al, gl = split_cols(p, RWKV_SPLIT)
    B, T, _ = r.shape
    heads = lambda t: t.reshape(B, T, RWKV_HEADS, RWKV_HEAD)
    g = jax.nn.sigmoid(gl) @ w_g2
    kk = heads(k * k_k).astype(jnp.float32)
    kk = kk / jnp.maximum(jnp.sqrt(jnp.sum(kk * kk, axis=-1, keepdims=True)), 1e-12)
    dirs = []
    for d in range(2):
        w_raw = -jax.nn.softplus(-(w0[d] + jnp.tanh(wl) @ w_w2[d]).astype(jnp.float32)) - 0.5
        decay = jnp.exp(-jnp.exp(w_raw))
        a = jax.nn.sigmoid(a0[d] + al @ w_a2[d])
        dirs.append((heads(decay), heads(k * (1 + (a - 1) * k_a)), heads(a)))
    return heads(r), heads(v), kk, g, dirs


def rwkv7_scan(r, w, k, v, kk, a, s0, with_out):
    tm = lambda t: jnp.moveaxis(t.astype(jnp.float32), 1, 0)
    xs = tuple(tm(t) for t in (w, k, v, kk, a)) + ((tm(r),) if with_out else ())

    def step(S, inp):
        w_t, k_t, v_t, kk_t, a_t = inp[:5]
        sa = jnp.einsum('bhvk,bhk->bhv', S, kk_t)
        S = S * w_t[:, :, None, :] - sa[..., None] * (kk_t * a_t)[:, :, None, :] + v_t[..., None] * k_t[:, :, None, :]
        if not with_out:
            return S, None
        return S, jnp.einsum('bhvk,bhk->bhv', S, inp[5])

    s_fin, y = lax.scan(step, s0, xs)
    if not with_out:
        return s_fin, None
    return s_fin, jnp.moveaxis(y, 0, 1)


def rwkv_out(y, r, kf, kb, v, g, r_k, gn_w, gn_b):
    B, T, H, N = y.shape
    mean = jnp.mean(y, axis=-1, keepdims=True)
    var = jnp.mean(jnp.square(y - mean), axis=-1, keepdims=True)
    yn = ((y - mean) * lax.rsqrt(var + RWKV_GN_EPS)).reshape(B, T, H * N) * gn_w + gn_b
    bonus = jnp.sum(r.astype(jnp.float32) * (kf + kb).astype(jnp.float32) * r_k, axis=-1, keepdims=True) * v.astype(jnp.float32)
    return ((yn + bonus.reshape(B, T, H * N)) * g.astype(jnp.float32)).astype(g.dtype)


def rwkv_branch(fz, fx, r_k, gn_w, gn_b, need_ctx):
    def run(f, s_f, s_b, with_out):
        r, v, kk, g, ((wf, kf, af), (wb, kb, ab)) = f
        sf, yf = rwkv7_scan(r, wf, kf, v, kk, af, s_f, with_out)
        sb, yb = rwkv7_scan(flip(r), flip(wb), flip(kb), flip(v), flip(kk), flip(ab), s_b, with_out)
        if not with_out:
            return sf, sb, None
        return sf, sb, rwkv_out(yf + flip(yb), r, kf, kb, v, g, r_k, gn_w, gn_b)

    s0 = jnp.zeros((fx[0].shape[0], RWKV_HEADS, RWKV_HEAD, RWKV_HEAD), jnp.float32)
    szf, szb, yz = run(fz, s0, s0, need_ctx)
    _, _, yx = run(fx, szf, szb, True)
    return yz, yx


def merge_branches(ys, gate_logits, w_branch, w_out):
    gates = jnp.split(gate_logits, N_BRANCH, axis=-1)
    m = jax.nn.sigmoid(gates[0]) * (ys[0] @ w_branch[0])
    for i in range(1, N_BRANCH):
        m = m + jax.nn.sigmoid(gates[i]) * (ys[i] @ w_branch[i])
    return m @ w_out


def mixer_sublayer(hz, hx, cos, sin, w_in, w_gk2, b_gk, g_gla, sink, mu_shift, w0, w_w2, a0, w_a2,
                   w_g2, k_k, k_a, r_k, gn_w, gn_b, w_branch, w_out, need_ctx):
    gla_z, swa_z, rwkv_z, gate_z = split_cols(hz @ w_in, GROUP_SPLIT)
    gla_x, swa_x, rwkv_x, gate_x = split_cols(hx @ w_in, GROUP_SPLIT)
    ya_z, ya_x = gla_branch(gla_features(gla_z, w_gk2, b_gk), gla_features(gla_x, w_gk2, b_gk), g_gla, need_ctx)
    qz, kz, vz = swa_features(swa_z)
    qx, kx, vx = swa_features(swa_x)
    yb_x = windowed_attention(apply_rope(qx, cos, sin), apply_rope(kx, cos, sin), vx, kz, vz, sink)
    rw = (mu_shift, w0, w_w2, a0, w_a2, w_g2, k_k, k_a)
    yc_z, yc_x = rwkv_branch(rwkv_features(rwkv_z, *rw), rwkv_features(rwkv_x, *rw), r_k, gn_w, gn_b, need_ctx)
    mx = merge_branches((ya_x, yb_x, yc_x), gate_x, w_branch, w_out)
    if not need_ctx:
        return None, mx
    yb_z = context_attention(qz, kz, vz, sink)
    mz = merge_branches((ya_z, yb_z, yc_z), gate_z, w_branch, w_out)
    return mz, mx


def setup_inputs(seed: int = 0) -> dict:
    key = jax.random.key(seed)
    ks = iter(jax.random.split(key, 32))
    f32 = jnp.float32
    nrm = lambda shape, scale: jax.random.normal(next(ks), shape, f32) * scale
    L, D = DEPTH, D_MODEL
    return {
        'x': nrm((BATCH, SEQ, D), 1.0),
        'c': nrm((BATCH, D), 1.0),
        'ctx': nrm((BATCH, CTX_LEN, D), 1.0),
        'c_ctx': nrm((D,), 1.0),
        'w_ada': nrm((L, D, 6 * D), 0.5 * D ** -0.5),
        'b_ada': nrm((L, 6 * D), 0.02),
        'g_mix': 1.0 + nrm((L, D), 0.02),
        'g_ffn': 1.0 + nrm((L, D), 0.02),
        'w_in': nrm((L, D, IN_WIDTH), D ** -0.5),
        'w_gk2': nrm((L, 2, GLA_GATE_RANK, GLA_HEADS * GLA_DK), GLA_GATE_RANK ** -0.5),
        'b_gk': nrm((L, 2, GLA_HEADS * GLA_DK), 0.5),
        'g_gla': 1.0 + nrm((L, GLA_DV), 0.02),
        'sink': nrm((L, SWA_Q_HEADS), 0.5),
        'mu_shift': jax.random.uniform(next(ks), (L, sum(RWKV_SPLIT)), f32),
        'w0': jax.random.uniform(next(ks), (L, 2, MIX_W), f32, -6.0, 1.0),
        'w_w2': nrm((L, 2, RWKV_DECAY_RANK, MIX_W), 0.5 * RWKV_DECAY_RANK ** -0.5),
        'a0': nrm((L, 2, MIX_W), 0.5),
        'w_a2': nrm((L, 2, RWKV_A_RANK, MIX_W), 0.5 * RWKV_A_RANK ** -0.5),
        'w_g2': nrm((L, RWKV_GATE_RANK, MIX_W), RWKV_GATE_RANK ** -0.5),
        'k_k': 0.85 + nrm((L, MIX_W), 0.05),
        'k_a': 1.0 + nrm((L, MIX_W), 0.05),
        'r_k': nrm((L, RWKV_HEADS, RWKV_HEAD), 0.1),
        'gn_w': 1.0 + nrm((L, MIX_W), 0.02),
        'gn_b': nrm((L, MIX_W), 0.02),
        'w_branch': nrm((L, N_BRANCH, MIX_W, D), MIX_W ** -0.5),
        'w_out': nrm((L, D, D), D ** -0.5),
        'w_ffn1': nrm((L, D, FFN_HIDDEN), D ** -0.5),
        'w_ffn3': nrm((L, D, FFN_HIDDEN), D ** -0.5),
        'w_ffn2': nrm((L, FFN_HIDDEN, D), FFN_HIDDEN ** -0.5),
        'g_final': 1.0 + nrm((D,), 0.02),
    }


def reference(x, c, ctx, c_ctx, w_ada, b_ada, g_mix, g_ffn, w_in, w_gk2, b_gk, g_gla, sink, mu_shift,
              w0, w_w2, a0, w_a2, w_g2, k_k, k_a, r_k, gn_w, gn_b, w_branch, w_out, w_ffn1, w_ffn3,
              w_ffn2, g_final):
    cos, sin = axial_rope(x.shape[1])
    z = ctx
    for l in range(DEPTH):
        need_ctx = l < DEPTH - 1
        mod_x = jax.nn.silu(c) @ w_ada[l] + b_ada[l]
        mod_z = (jax.nn.silu(c_ctx) @ w_ada[l] + b_ada[l])[None]
        sh1x, sc1x, ga1x, sh2x, sc2x, ga2x = jnp.split(mod_x, 6, axis=-1)
        sh1z, sc1z, ga1z, sh2z, sc2z, ga2z = jnp.split(mod_z, 6, axis=-1)
        hx = modulate(rmsnorm(x, g_mix[l]), sh1x, sc1x)
        hz = modulate(rmsnorm(z, g_mix[l]), sh1z, sc1z)
        mz, mx = mixer_sublayer(hz, hx, cos, sin, w_in[l], w_gk2[l], b_gk[l], g_gla[l], sink[l], mu_shift[l],
                                w0[l], w_w2[l], a0[l], w_a2[l], w_g2[l], k_k[l], k_a[l], r_k[l], gn_w[l],
                                gn_b[l], w_branch[l], w_out[l], need_ctx)
        x = x + ga1x[:, None] * mx
        x = x + ga2x[:, None] * swiglu(modulate(rmsnorm(x, g_ffn[l]), sh2x, sc2x), w_ffn1[l], w_ffn3[l], w_ffn2[l])
        if need_ctx:
            z = z + ga1z[:, None] * mz
            z = z + ga2z[:, None] * swiglu(modulate(rmsnorm(z, g_ffn[l]), sh2z, sc2z), w_ffn1[l], w_ffn3[l], w_ffn2[l])
    return rmsnorm(x, g_final)
```

```cpp
#include <hip/hip_runtime.h>
#include <cstdio>
#include <cstdint>

#ifndef MK_SINGLE
#define MK_SINGLE 0
#endif

#define LAS __attribute__((address_space(3)))
#define GAS __attribute__((address_space(1)))
typedef unsigned short bf16_t;
typedef short bf16x8 __attribute__((ext_vector_type(8)));
typedef float f32x4 __attribute__((ext_vector_type(4)));
typedef float f32x2 __attribute__((ext_vector_type(2)));
typedef unsigned u32x4 __attribute__((ext_vector_type(4)));
typedef unsigned u32x2 __attribute__((ext_vector_type(2)));

constexpr int D = 1024, NB = 4, T = 4096, CL = 256, DEPTH = 2;
constexpr int MLAT = NB * T;
constexpr int MCTX = NB * CL;
constexpr int MTOT = MLAT + MCTX;
constexpr int INW = 7200;
constexpr int FF = 2816;
constexpr int LDP = 4224, NPW = 4352;
constexpr int PC_OG = 0, PC_SQ = 512, PC_RR = 1024, PC_GQ = 1536, PC_GK = 1792, PC_GV = 2048, PC_SK = 2560, PC_SV = 2688,
              PC_RK = 2816, PC_RV = 3328, PC_WL = 3840, PC_AL = 3904, PC_GL = 3968, PC_GKF = 4096, PC_GKB = 4112;
constexpr int PC_YA = PC_OG, PC_YB = PC_SQ, PC_YC = PC_RR;
constexpr int PC_B0 = 1536, PC_B1 = 2560;

constexpr size_t MiB = 1u << 20;
constexpr size_t WS_CTL = 0, CTL_ZERO_BYTES = 64 * 1024;
constexpr size_t WS_MOD = 1 * MiB;
constexpr size_t WS_ROPE = WS_MOD + 256 * 1024;
constexpr size_t WS_Z = 2 * MiB;
constexpr size_t WS_W = 6 * MiB;
constexpr size_t WO_IN = 0;
constexpr size_t WO_G = WO_IN + (size_t)NPW * D * 2;
constexpr size_t WO_B = WO_G + (size_t)3072 * D * 2;
constexpr size_t WO_O = WO_B + (size_t)3 * D * 512 * 2;
constexpr size_t WO_13 = WO_O + (size_t)D * D * 2;
constexpr size_t WO_2 = WO_13 + (size_t)2 * FF * D * 2;
constexpr size_t WO_END = WO_2 + (size_t)D * FF * 2;
static_assert(WO_END <= 36 * MiB, "weights region");
constexpr size_t WS_H = 42 * MiB;
constexpr size_t WS_P = 76 * MiB;
constexpr size_t WS_F = 217 * MiB;
constexpr size_t WS_C = 251 * MiB;
constexpr size_t WS_END = 253 * MiB;
static_assert(WS_P + (size_t)MTOT * LDP * 2 <= WS_F && WS_H + (size_t)MTOT * D * 2 <= WS_P && WS_F + (size_t)MTOT * D * 2 <= WS_C && WS_C + (size_t)MTOT * 16 * 4 <= WS_END, "ws map");
constexpr int CW_BAR = 1024;

constexpr int NWAVES = 8, NTHR = 512;
constexpr int LDS_BYTES = 147456;
constexpr int LDS_MISC = 131072 + 8192;

__device__ __forceinline__ float bf2f(unsigned b) { return __uint_as_float(b << 16); }
__device__ __forceinline__ unsigned f2bf(float f) { unsigned u = __float_as_uint(f); return (u + 0x7fffu + ((u >> 16) & 1u)) >> 16; }
__device__ __forceinline__ unsigned pk2(float lo, float hi) { return f2bf(lo) | (f2bf(hi) << 16); }
__device__ __forceinline__ float bflo(unsigned w) { return __uint_as_float(w << 16); }
__device__ __forceinline__ float bfhi(unsigned w) { return __uint_as_float(w & 0xffff0000u); }
__device__ __forceinline__ float wave_sum(float v) {
#pragma unroll
    for (int o = 32; o >= 1; o >>= 1) v += __shfl_xor(v, o);
    return v;
}
__device__ __forceinline__ float sum16(float v) {
    v += __shfl_xor(v, 1); v += __shfl_xor(v, 2); v += __shfl_xor(v, 4); v += __shfl_xor(v, 8);
    return v;
}
__device__ __forceinline__ float sigmoidf_(float x) { return 1.0f / (1.0f + __expf(-x)); }
__device__ __forceinline__ float siluf_(float x) { return x / (1.0f + __expf(-x)); }
__device__ __forceinline__ float softplusf_(float x) { return fmaxf(x, 0.f) + log1pf(__expf(-fabsf(x))); }

#define XB_TMO      128
#define XB_XCNT(j)  (256  + 64 * (j))
#define XB_XSUB(j)  (1280 + 64 * (j))
#define XB_XGEN(j)  (2304 + 64 * (j))
#define XB_TOP      3328
#define XB_TOPGEN   3392
#define XCD_BAR_WORDS 3456
#define XB_SPIN_CAP (1u << 22)
__device__ __forceinline__ unsigned xb_ld(unsigned* p)              { return __hip_atomic_load(p, __ATOMIC_RELAXED, __HIP_MEMORY_SCOPE_AGENT); }
__device__ __forceinline__ unsigned xb_add(unsigned* p, unsigned v) { return __hip_atomic_fetch_add(p, v, __ATOMIC_RELAXED, __HIP_MEMORY_SCOPE_AGENT); }
__device__ __forceinline__ unsigned xb_xcc_id() { return (unsigned)__builtin_amdgcn_s_getreg((3 << 11) | 20) & 0xFu; }
#define XB_SPIN(cond, bar) do { unsigned _sp = 0; while (cond) { __builtin_amdgcn_s_sleep(1); \
    if ((++_sp & 255u) == 0u) { if (xb_ld(&(bar)[XB_TMO])) break; if (_sp > XB_SPIN_CAP) { atomicAdd(&(bar)[XB_TMO], 1u); break; } } } } while (0)
struct XcdBarrier { unsigned* bar; unsigned x; volatile LAS unsigned* st; };
__device__ __forceinline__ XcdBarrier xcd_barrier_post(unsigned* bar, volatile LAS unsigned* st) {
    XcdBarrier b; b.bar = bar; b.x = xb_xcc_id(); b.st = st;
    if (threadIdx.x == 0) (void)xb_add(&bar[XB_XCNT(b.x)], 1u);
    return b;
}
__device__ __forceinline__ void xcd_barrier_complete(unsigned* bar, unsigned x, unsigned& nloc, unsigned& nx) {
    const unsigned G = gridDim.x * gridDim.y * gridDim.z;
    unsigned sum, cnt, mine, sp = 0u;
    for (;;) {
        sum = 0u; cnt = 0u; mine = 0u;
#pragma unroll
        for (unsigned j = 0; j < 16; ++j) { const unsigned c = xb_ld(&bar[XB_XCNT(j)]); sum += c; cnt += (c > 0u) ? 1u : 0u; mine = (j == x) ? c : mine; }
        if (sum == G) break;
        __builtin_amdgcn_s_sleep(1);
        if ((++sp & 255u) == 0u) { if (xb_ld(&bar[XB_TMO])) break; if (sp > XB_SPIN_CAP) { atomicAdd(&bar[XB_TMO], 1u); break; } }
    }
    nloc = mine > 0u ? mine : 1u; nx = cnt > 0u ? cnt : 1u;
}
__device__ __forceinline__ void xcd_barrier(const XcdBarrier& b) {
    asm volatile("s_waitcnt vmcnt(0)" ::: "memory");
    __syncthreads();
    if (threadIdx.x == 0) {
        unsigned* bar = b.bar;
        __builtin_amdgcn_s_waitcnt(0);
        unsigned nloc = b.st[0], nx = b.st[1];
        if (nloc == 0u) { xcd_barrier_complete(bar, b.x, nloc, nx); b.st[0] = nloc; b.st[1] = nx; }
        const unsigned old = xb_add(&bar[XB_XSUB(b.x)], 1u);
        const unsigned gen = old / nloc;
        if (old + 1u == (gen + 1u) * nloc) {
            __builtin_amdgcn_fence(__ATOMIC_RELEASE, "agent");
            asm volatile("s_waitcnt vmcnt(0)" ::: "memory");
            const unsigned og = xb_add(&bar[XB_TOP], 1u);
            const unsigned tg = og / nx;
            if (og + 1u == (tg + 1u) * nx) xb_add(&bar[XB_TOPGEN], 1u);
            else XB_SPIN(xb_ld(&bar[XB_TOPGEN]) == tg, bar);
            __builtin_amdgcn_fence(__ATOMIC_ACQUIRE, "agent");
            xb_add(&bar[XB_XGEN(b.x)], 1u);
            asm volatile("s_waitcnt vmcnt(0)" ::: "memory");
        } else {
            XB_SPIN(xb_ld(&bar[XB_XGEN(b.x)]) == gen, bar);
            __builtin_amdgcn_fence(__ATOMIC_ACQUIRE, "agent");
            asm volatile("s_waitcnt vmcnt(0)" ::: "memory");
        }
    }
    __syncthreads();
}

namespace pg8 {
constexpr int BM = 256, BK = 64, HALF = 128, HTB = HALF * BK * 2, STAGE_BYTES = 8 * HTB, NXCD = 8, WGM = 8;
__host__ __device__ __forceinline__ int lds_byte(int r, int c) { const int st = (r >> 4) * 2 + (c >> 5), rr = r & 15, cc = c & 31, ob = rr * 64 + cc * 2; return st * 1024 + (ob ^ (((ob >> 9) & 1) << 5)); }
__host__ __device__ __forceinline__ void stage_rc(int b, int& R, int& C) { const int st = b / 1024, sb = b % 1024, swz = sb ^ (((sb >> 9) & 1) << 5); R = (st >> 1) * 16 + swz / 64; C = (st & 1) * 32 + (swz % 64) / 2; }
__host__ __device__ __forceinline__ int perm32(int rho) { const int n = rho >> 4, i = rho & 15; return 8 * (i >> 2) + 4 * n + (i & 3); }
struct Unit { int pm, pn; const char* a; const char* b; };
struct Dims { int K, lda, ldb; };
struct TileOrder {
    int nM, nN, nwg, G, c;
    __device__ __forceinline__ void init(int nM_, int nN_, int G_, int c_) { nM = nM_; nN = nN_; nwg = nM * nN; G = G_; c = c_; }
    __device__ __forceinline__ bool tile(int i, int& pm, int& pn) const {
        const long L = (long)i * G + c; if (L >= nwg) return false;
        int wgid = (int)L; { const int q = nwg / NXCD, r = nwg % NXCD, xcd = wgid % NXCD, off = wgid / NXCD; wgid = (xcd < r ? xcd * (q + 1) : r * (q + 1) + (xcd - r) * q) + off; }
        const int nig = WGM * nN, gid = wgid / nig, fm = gid * WGM, gsz = (nM - fm) < WGM ? (nM - fm) : WGM;
        pm = fm + ((wgid % nig) % gsz); pn = (wgid % nig) / gsz; return true;
    }
};
__device__ __forceinline__ unsigned cvt_pk_bf16(float lo, float hi) { unsigned r; asm volatile("v_cvt_pk_bf16_f32 %0, %1, %2" : "=v"(r) : "v"(lo), "v"(hi)); return r; }

template <class Epi, class Sched>
__device__ __forceinline__ void gemm_phase(LAS unsigned char* lds, const Dims g, const Sched& S, const Epi& E) {
    const int tid = threadIdx.x, wid = __builtin_amdgcn_readfirstlane(tid >> 6), lane = tid & 63, wr = wid >> 2, wc = wid & 3, fr = lane & 15, fq = lane >> 4;
    const int K = g.K, nt = K / BK;
    unsigned voffA[2], voffB[2];
#pragma unroll
    for (int i = 0; i < 2; ++i) { int R, C; stage_rc(tid * 16 + i * 8192, R, C); const int Rb = Epi::PERM ? ((R & ~31) + perm32(R & 31)) : R;
        voffA[i] = (unsigned)(R * g.lda + C) * 2u; voffB[i] = (unsigned)(Rb * g.ldb + C) * 2u; }
    const size_t kstep = (size_t)(BK * 2);
    const size_t hstepA = (size_t)HALF * g.lda * 2, hstepB = (size_t)HALF * g.ldb * 2;
    const unsigned ldsw = (unsigned)wid * 1024u;
    const int aoff = lds_byte(wr * 64 + fr, fq * 8), boff = lds_byte(wc * 32 + fr, fq * 8);
#define PG8_SA(b, h) (((b) * 2 + (h)) * HTB)
#define PG8_SB(b, h) ((4 + (b) * 2 + (h)) * HTB)
#define PG8_STAGE(bufoff, gbase, voff) do { _Pragma("unroll") for (int _i = 0; _i < 2; ++_i) \
        __builtin_amdgcn_global_load_lds((const unsigned*)((const char*)(gbase) + (voff)[_i]), (LAS unsigned*)(lds + (bufoff) + ldsw + _i * 8192), 16, 0, 0); } while (0)
#define PG8_LDA(dst, b, h) do { _Pragma("unroll") for (int m = 0; m < 4; ++m) _Pragma("unroll") for (int k = 0; k < 2; ++k) dst[m][k] = *(const LAS bf16x8*)(lds + PG8_SA(b, h) + aoff + m * 2048 + k * 1024); } while (0)
#define PG8_LDB(dst, b, h) do { _Pragma("unroll") for (int n = 0; n < 2; ++n) _Pragma("unroll") for (int k = 0; k < 2; ++k) dst[n][k] = *(const LAS bf16x8*)(lds + PG8_SB(b, h) + boff + n * 2048 + k * 1024); } while (0)
#define PG8_MMA(ai, bj, At, Bt) do { __builtin_amdgcn_s_setprio(1); _Pragma("unroll") for (int m = 0; m < 4; ++m) _Pragma("unroll") for (int n = 0; n < 2; ++n) _Pragma("unroll") for (int k = 0; k < 2; ++k) \
        acc[ai][bj][m][n] = __builtin_amdgcn_mfma_f32_16x16x32_bf16(Bt[n][k], At[m][k], acc[ai][bj][m][n], 0, 0, 0); __builtin_amdgcn_s_setprio(0); } while (0)
#define PG8_WAIT_V(n) asm volatile("s_waitcnt vmcnt(" #n ")" ::: "memory")
#define PG8_WAIT_L(n) asm volatile("s_waitcnt lgkmcnt(" #n ")" ::: "memory")
#define PG8_BAR __builtin_amdgcn_s_barrier()
#define PG8_SCHED __builtin_amdgcn_sched_barrier(0)
    Unit cur, nxt; int ui = 0;
    if (!S.next(0, cur)) return;
    f32x4 acc[2][2][4][2];
#pragma unroll
    for (int a = 0; a < 2; ++a)
#pragma unroll
        for (int b = 0; b < 2; ++b)
#pragma unroll
            for (int m = 0; m < 4; ++m)
#pragma unroll
                for (int n = 0; n < 2; ++n) acc[a][b][m][n] = (f32x4){0.f, 0.f, 0.f, 0.f};
    bf16x8 At[4][2], B0[2][2], B1[2][2];
    const char* cA = cur.a; const char* cB = cur.b;
    PG8_STAGE(PG8_SB(0, 0), cB, voffB); PG8_STAGE(PG8_SB(0, 1), cB + hstepB, voffB); PG8_STAGE(PG8_SA(0, 0), cA, voffA); PG8_STAGE(PG8_SA(0, 1), cA + hstepA, voffA);
    if (wr == 1) PG8_BAR;
    PG8_WAIT_V(2); PG8_BAR;
    PG8_STAGE(PG8_SB(1, 0), cB + kstep, voffB); PG8_STAGE(PG8_SA(1, 0), cA + kstep, voffA); PG8_STAGE(PG8_SB(1, 1), cB + hstepB + kstep, voffB);
    PG8_WAIT_V(6); PG8_BAR;
    for (;;) {
        const bool has_next = S.next(ui + 1, nxt);
        const char* nA = has_next ? nxt.a : cA; const char* nB = has_next ? nxt.b : cB;
        for (int t = 0; t < nt; t += 2) {
            const bool last = (t == nt - 2);
            const char* a1 = cA + (size_t)(t + 1) * kstep;
            const char* a2 = last ? nA : cA + (size_t)(t + 2) * kstep; const char* b2 = last ? nB : cB + (size_t)(t + 2) * kstep;
            const char* a3 = a2 + kstep; const char* b3 = b2 + kstep;
            PG8_LDB(B0, 0, 0); PG8_LDB(B1, 0, 1); PG8_SCHED; PG8_LDA(At, 0, 0); PG8_STAGE(PG8_SA(1, 1), a1 + hstepA, voffA);
            PG8_WAIT_V(8); PG8_WAIT_L(0); PG8_BAR; PG8_MMA(0, 0, At, B0); PG8_MMA(0, 1, At, B1); PG8_BAR; PG8_SCHED;
            PG8_LDA(At, 0, 1); PG8_STAGE(PG8_SB(0, 0), b2, voffB); PG8_STAGE(PG8_SB(0, 1), b2 + hstepB, voffB); PG8_STAGE(PG8_SA(0, 0), a2, voffA);
            PG8_WAIT_V(8); PG8_WAIT_L(0); PG8_BAR; PG8_MMA(1, 0, At, B0); PG8_MMA(1, 1, At, B1); PG8_BAR; PG8_SCHED;
            PG8_LDB(B0, 1, 0); PG8_LDB(B1, 1, 1); PG8_SCHED; PG8_LDA(At, 1, 0); PG8_STAGE(PG8_SA(0, 1), a2 + hstepA, voffA);
            PG8_WAIT_V(8); PG8_WAIT_L(0); PG8_BAR; PG8_MMA(0, 0, At, B0); PG8_MMA(0, 1, At, B1); PG8_BAR; PG8_SCHED;
            PG8_LDA(At, 1, 1); PG8_STAGE(PG8_SB(1, 0), b3, voffB); PG8_STAGE(PG8_SB(1, 1), b3 + hstepB, voffB); PG8_STAGE(PG8_SA(1, 0), a3, voffA);
            PG8_WAIT_V(8); PG8_WAIT_L(0); PG8_BAR; PG8_MMA(1, 0, At, B0); PG8_MMA(1, 1, At, B1); PG8_BAR; PG8_SCHED;
        }
        if (wr == 0) PG8_BAR;
        E(acc, cur, wr, wc, fr, fq);
        if (!has_next) break;
#pragma unroll
        for (int a = 0; a < 2; ++a)
#pragma unroll
            for (int b = 0; b < 2; ++b)
#pragma unroll
                for (int m = 0; m < 4; ++m)
#pragma unroll
                    for (int n = 0; n < 2; ++n) acc[a][b][m][n] = (f32x4){0.f, 0.f, 0.f, 0.f};
        cur = nxt; cA = nA; cB = nB; ++ui;
        if (wr == 1) PG8_BAR;
    }
    PG8_WAIT_V(0);
    PG8_BAR;
#undef PG8_SA
#undef PG8_SB
#undef PG8_STAGE
#undef PG8_LDA
#undef PG8_LDB
#undef PG8_MMA
#undef PG8_WAIT_V
#undef PG8_WAIT_L
#undef PG8_BAR
#undef PG8_SCHED
}
}

struct KArgs { const float* in[30]; float* out; unsigned char* ws; int ph_lo, ph_hi; };
struct Frame {
    LAS unsigned char* lds; int tid, lane, wave, G, bid;
    const float* const* in; float* out; unsigned char* ws;
    __device__ __forceinline__ const float* I(int k) const { return in[k]; }
    __device__ __forceinline__ float* mod() const { return (float*)(ws + WS_MOD); }
    __device__ __forceinline__ float* rope() const { return (float*)(ws + WS_ROPE); }
    __device__ __forceinline__ float* Z() const { return (float*)(ws + WS_Z); }
    __device__ __forceinline__ bf16_t* W(size_t off) const { return (bf16_t*)(ws + WS_W + off); }
    __device__ __forceinline__ bf16_t* H() const { return (bf16_t*)(ws + WS_H); }
    __device__ __forceinline__ bf16_t* P() const { return (bf16_t*)(ws + WS_P); }
    __device__ __forceinline__ bf16_t* Fb() const { return (bf16_t*)(ws + WS_F); }
    __device__ __forceinline__ float* Cb() const { return (float*)(ws + WS_C); }
};
enum { IN_X = 0, IN_C, IN_CTX, IN_CCTX, IN_WADA, IN_BADA, IN_GMIX, IN_GFFN, IN_WIN, IN_WGK2, IN_BGK, IN_GGLA, IN_SINK, IN_MU, IN_W0, IN_WW2, IN_A0, IN_WA2, IN_WG2,
       IN_KK, IN_KA, IN_RK, IN_GNW, IN_GNB, IN_WBR, IN_WOUT, IN_WF1, IN_WF3, IN_WF2, IN_GFIN };

__device__ __forceinline__ void ph_mods(const Frame& F) {
    LAS float* sc = (LAS float*)F.lds;
    LAS float* red = sc + 5 * 1024;
    for (int i = F.tid; i < 5 * 1024; i += NTHR) { const int r = i >> 10, k = i & 1023; const float v = r < 4 ? F.I(IN_C)[r * 1024 + k] : F.I(IN_CCTX)[k]; sc[i] = siluf_(v); }
    __syncthreads();
    for (int item = F.bid; item < 2 * 96; item += F.G) {
        const int l = item / 96, n0 = (item % 96) * 64;
        const float* Wp = F.I(IN_WADA) + (size_t)l * 1024 * 6144 + n0 + F.lane;
        float acc[5] = {0.f, 0.f, 0.f, 0.f, 0.f};
#pragma unroll 8
        for (int kk = 0; kk < 128; ++kk) { const int k = F.wave * 128 + kk; const float w = Wp[(size_t)k * 6144];
#pragma unroll
            for (int r = 0; r < 5; ++r) acc[r] += sc[r * 1024 + k] * w; }
#pragma unroll
        for (int r = 0; r < 5; ++r) red[(F.wave * 5 + r) * 64 + F.lane] = acc[r];
        __syncthreads();
        if (F.tid < 320) { const int r = F.tid >> 6, ln = F.tid & 63; float s = 0.f;
#pragma unroll
            for (int w = 0; w < 8; ++w) s += red[(w * 5 + r) * 64 + ln];
            F.mod()[(size_t)(l * 5 + r) * 6144 + n0 + ln] = s + F.I(IN_BADA)[l * 6144 + n0 + ln]; }
        __syncthreads();
    }
    if (F.bid == (F.G > 200 ? 200 : 0)) {
        for (int idx = F.tid; idx < 1024; idx += NTHR) {
            const int pos = idx >> 4, f = idx & 15;
            const float inv = exp2f(-(float)f * (1.0f / 16.0f) * 13.287712379549449f);
            const float ang = (float)pos * inv;
            const double x = (double)ang;
            const double kq = __builtin_rint(x * 0.63661977236758134308);
            const double r = x - kq * 1.57079632679489661923 - kq * 6.123233995736766e-17;
            const double r2 = r * r;
            double sn = r * (1.0 + r2 * (-1.0 / 6.0 + r2 * (1.0 / 120.0 + r2 * (-1.0 / 5040.0 + r2 * (1.0 / 362880.0 + r2 * (-1.0 / 39916800.0 + r2 * (1.0 / 6227020800.0 + r2 * (-1.0 / 1307674368000.0))))))));
            double cs = 1.0 + r2 * (-0.5 + r2 * (1.0 / 24.0 + r2 * (-1.0 / 720.0 + r2 * (1.0 / 40320.0 + r2 * (-1.0 / 3628800.0 + r2 * (1.0 / 479001600.0 + r2 * (-1.0 / 87178291200.0)))))));
            const int q = ((int)kq) & 3;
            double co, si;
            if (q == 0) { co = cs; si = sn; } else if (q == 1) { co = -sn; si = cs; } else if (q == 2) { co = -cs; si = -sn; } else { co = sn; si = -cs; }
            F.rope()[idx] = (float)co; F.rope()[1024 + idx] = (float)si;
        }
    }
}

template <class ColPtr>
__device__ __forceinline__ void conv_weight(const Frame& F, int ld, int K, bf16_t* dst, int nrows, const ColPtr& colptr) {
    const int gw = F.bid * NWAVES + F.wave, NGW = F.G * NWAVES;
    const int kch = K / 32, nitems = (nrows / 64) * kch;
    for (int it = gw; it < nitems; it += NGW) {
        const int rg = it / kch, kc = it % kch, j = rg * 64 + F.lane, k0 = kc * 32;
        const float* sp = colptr(j);
        unsigned w[16];
        if (sp) { sp += (size_t)k0 * ld;
#pragma unroll
            for (int i = 0; i < 16; ++i) { const float a = sp[(size_t)(2 * i) * ld], b = sp[(size_t)(2 * i + 1) * ld]; w[i] = pk2(a, b); }
        } else {
#pragma unroll
            for (int i = 0; i < 16; ++i) w[i] = 0u;
        }
        u32x4* dp = (u32x4*)(dst + (size_t)j * K + k0);
#pragma unroll
        for (int i = 0; i < 4; ++i) dp[i] = (u32x4){w[4 * i], w[4 * i + 1], w[4 * i + 2], w[4 * i + 3]};
    }
}
__device__ __forceinline__ int win_srccol(int j) {
    if (j < 512) return 1056 + j;
    if (j < 1024) return 1568 + (j - 512);
    if (j < 1536) return 2336 + (j - 1024);
    if (j < 1792) return j - 1536;
    if (j < 2048) return 256 + (j - 1792);
    if (j < 2560) return 512 + (j - 2048);
    if (j < 2688) return 2080 + (j - 2560);
    if (j < 2816) return 2208 + (j - 2688);
    if (j < 3328) return 2848 + (j - 2816);
    if (j < 3840) return 3360 + (j - 3328);
    if (j < 3904) return 3872 + (j - 3840);
    if (j < 3968) return 3936 + (j - 3904);
    if (j < 4096) return 4000 + (j - 3968);
    if (j < 4112) return 1024 + (j - 4096);
    if (j < 4128) return 1040 + (j - 4112);
    return -1;
}
__device__ __forceinline__ void ph_convert_weights(const Frame& F, int l) {
    const float* win = F.I(IN_WIN) + (size_t)l * D * INW;
    conv_weight(F, INW, D, F.W(WO_IN), NPW, [=](int j) -> const float* { const int c = win_srccol(j); return c < 0 ? nullptr : win + c; });
    conv_weight(F, INW, D, F.W(WO_G), 3072, [=](int j) -> const float* { return win + 4128 + j; });
    for (int i = 0; i < 3; ++i) { const float* wb = F.I(IN_WBR) + (size_t)(l * 3 + i) * 512 * D;
        conv_weight(F, D, 512, F.W(WO_B) + (size_t)i * D * 512, D, [=](int j) -> const float* { return wb + j; }); }
    { const float* wo = F.I(IN_WOUT) + (size_t)l * D * D; conv_weight(F, D, D, F.W(WO_O), D, [=](int j) -> const float* { return wo + j; }); }
    { const float* w1 = F.I(IN_WF1) + (size_t)l * D * FF; const float* w3 = F.I(IN_WF3) + (size_t)l * D * FF;
      conv_weight(F, FF, D, F.W(WO_13), 2 * FF, [=](int j) -> const float* { const int hc = (j >> 8) * 128 + (j & 127); return ((j >> 7) & 1) ? w3 + hc : w1 + hc; }); }
    { const float* w2 = F.I(IN_WF2) + (size_t)l * FF * D; conv_weight(F, D, FF, F.W(WO_2), D, [=](int j) -> const float* { return w2 + j; }); }
}

__device__ __forceinline__ void prep_row(const Frame& F, const float* src, const float* g, const float* sh, const float* sc, bf16_t* dst) {
    const f32x4* xr = (const f32x4*)src + F.lane;
    f32x4 v[4]; float s = 0.f;
#pragma unroll
    for (int j = 0; j < 4; ++j) { v[j] = xr[64 * j]; s += (v[j].x * v[j].x + v[j].y * v[j].y) + (v[j].z * v[j].z + v[j].w * v[j].w); }
    const float rstd = 1.0f / sqrtf(wave_sum(s) * (1.0f / D) + 1e-6f);
    u32x2* o8 = (u32x2*)dst + F.lane;
#pragma unroll
    for (int j = 0; j < 4; ++j) {
        const f32x4 gg = ((const f32x4*)g)[F.lane + 64 * j], s1 = ((const f32x4*)sc)[F.lane + 64 * j], s0 = ((const f32x4*)sh)[F.lane + 64 * j];
        const f32x4 y = (v[j] * rstd * gg) * (s1 + 1.0f) + s0;
        o8[64 * j] = (u32x2){pk2(y.x, y.y), pk2(y.z, y.w)};
    }
}
__device__ __forceinline__ void ph_prep_h(const Frame& F, int l, int which, int nrows, const float* xlat, const float* xctx) {
    const int gw = F.bid * NWAVES + F.wave, NGW = F.G * NWAVES;
    const float* g = (which == 0 ? F.I(IN_GMIX) : F.I(IN_GFFN)) + l * D;
    for (int m = gw; m < nrows; m += NGW) {
        const float* src = m < MLAT ? xlat + (size_t)m * D : xctx + (size_t)(m - MLAT) * D;
        const int mr = m < MLAT ? (m >> 12) : 4;
        const float* md = F.mod() + (size_t)(l * 5 + mr) * 6144 + (which ? 3 * D : 0);
        prep_row(F, src, g, md, md + D, F.H() + (size_t)m * D);
    }
}

struct SchedPlain {
    pg8::TileOrder o; const char* A; const char* B; size_t tA, tB;
    __device__ __forceinline__ bool next(int i, pg8::Unit& u) const { if (!o.tile(i, u.pm, u.pn)) return false; u.a = A + (size_t)u.pm * tA; u.b = B + (size_t)u.pn * tB; return true; }
};
struct SchedBranch {
    pg8::TileOrder o; const char* Pb; const char* Wb;
    __device__ __forceinline__ bool next(int i, pg8::Unit& u) const { if (!o.tile(i, u.pm, u.pn)) return false; const int br = u.pn >> 2, pn = u.pn & 3;
        u.a = Pb + (size_t)u.pm * 256 * LDP * 2 + (size_t)br * 512 * 2; u.b = Wb + (size_t)br * D * 512 * 2 + (size_t)pn * 256 * 512 * 2; return true; }
};
typedef f32x4 AccT[2][2][4][2];
struct EpiStoreP {
    static constexpr bool PERM = true; bf16_t* O;
    __device__ __forceinline__ void operator()(const AccT& acc, const pg8::Unit& u, int wr, int wc, int fr, int fq) const {
        const int row0 = u.pm * 256 + wr * 64 + fr, col0 = u.pn * 256 + wc * 32 + 8 * fq;
#pragma unroll
        for (int ai = 0; ai < 2; ++ai)
#pragma unroll
            for (int m = 0; m < 4; ++m) { bf16_t* rowp = O + (size_t)(row0 + ai * 128 + m * 16) * LDP + col0;
#pragma unroll
                for (int bj = 0; bj < 2; ++bj) if (col0 + bj * 128 < LDP) { const f32x4 v0 = acc[ai][bj][m][0], v1 = acc[ai][bj][m][1];
                    *(u32x4*)(rowp + bj * 128) = (u32x4){pk2(v0[0], v0[1]), pk2(v0[2], v0[3]), pk2(v1[0], v1[1]), pk2(v1[2], v1[3])}; } }
    }
};
struct BranchDst { bf16_t* pb; bf16_t* fb; };
struct EpiBranch {
    static constexpr bool PERM = true; BranchDst d;
    __device__ __forceinline__ void operator()(const AccT& acc, const pg8::Unit& u, int wr, int wc, int fr, int fq) const {
        const int br = u.pn >> 2, pn = u.pn & 3; const bool lastb = br == 2; bf16_t* O = lastb ? d.fb : d.pb + PC_B0 + br * 1024; const int ldc = lastb ? D : LDP;
        const int row0 = u.pm * 256 + wr * 64 + fr, col0 = pn * 256 + wc * 32 + 8 * fq;
#pragma unroll
        for (int ai = 0; ai < 2; ++ai)
#pragma unroll
            for (int m = 0; m < 4; ++m) { bf16_t* rowp = O + (size_t)(row0 + ai * 128 + m * 16) * ldc + col0;
#pragma unroll
                for (int bj = 0; bj < 2; ++bj) { const f32x4 v0 = acc[ai][bj][m][0], v1 = acc[ai][bj][m][1];
                    *(u32x4*)(rowp + bj * 128) = (u32x4){pk2(v0[0], v0[1]), pk2(v0[2], v0[3]), pk2(v1[0], v1[1]), pk2(v1[2], v1[3])}; } }
    }
};
struct EpiGate {
    static constexpr bool PERM = true; BranchDst d;
    __device__ __forceinline__ void operator()(const AccT& acc, const pg8::Unit& u, int wr, int wc, int fr, int fq) const {
        const int br = u.pn >> 2, pn = u.pn & 3; const bool lastb = br == 2; bf16_t* O = lastb ? d.fb : d.pb + PC_B0 + br * 1024; const int ldc = lastb ? D : LDP;
        const int row0 = u.pm * 256 + wr * 64 + fr, col0 = pn * 256 + wc * 32 + 8 * fq;
#pragma unroll
        for (int ai = 0; ai < 2; ++ai)
#pragma unroll
            for (int m = 0; m < 4; ++m) { bf16_t* rowp = O + (size_t)(row0 + ai * 128 + m * 16) * ldc + col0;
#pragma unroll
                for (int bj = 0; bj < 2; ++bj) { const f32x4 v0 = acc[ai][bj][m][0], v1 = acc[ai][bj][m][1];
                    const u32x4 b = *(const u32x4*)(rowp + bj * 128);
                    u32x4 o;
                    o.x = pk2(sigmoidf_(v0[0]) * bflo(b.x), sigmoidf_(v0[1]) * bfhi(b.x)); o.y = pk2(sigmoidf_(v0[2]) * bflo(b.y), sigmoidf_(v0[3]) * bfhi(b.y));
                    o.z = pk2(sigmoidf_(v1[0]) * bflo(b.z), sigmoidf_(v1[1]) * bfhi(b.z)); o.w = pk2(sigmoidf_(v1[2]) * bflo(b.w), sigmoidf_(v1[3]) * bfhi(b.w));
                    *(u32x4*)(rowp + bj * 128) = o; } }
    }
};
struct EpiRes {
    static constexpr bool PERM = false; const float* xin_lat; const float* xin_ctx; float* out_lat; float* out_ctx; const float* modl; int gaoff;
    __device__ __forceinline__ void operator()(const AccT& acc, const pg8::Unit& u, int wr, int wc, int fr, int fq) const {
        const bool lat = u.pm < 64; const int prow = lat ? u.pm * 256 : (u.pm - 64) * 256;
        const float* xin = lat ? xin_lat : xin_ctx; float* out = lat ? out_lat : out_ctx;
        const float* ga = modl + (size_t)(lat ? (u.pm >> 4) : 4) * 6144 + gaoff;
        const int row0 = prow + wr * 64 + fr, col0 = u.pn * 256 + wc * 32 + 4 * fq;
        f32x4 gv[2][2];
#pragma unroll
        for (int bj = 0; bj < 2; ++bj)
#pragma unroll
            for (int n = 0; n < 2; ++n) gv[bj][n] = *(const f32x4*)(ga + col0 + bj * 128 + n * 16);
#pragma unroll
        for (int ai = 0; ai < 2; ++ai)
#pragma unroll
            for (int m = 0; m < 4; ++m) { const size_t off = (size_t)(row0 + ai * 128 + m * 16) * D + col0;
#pragma unroll
                for (int bj = 0; bj < 2; ++bj)
#pragma unroll
                    for (int n = 0; n < 2; ++n) { const f32x4 xi = *(const f32x4*)(xin + off + bj * 128 + n * 16);
                        *(f32x4*)(out + off + bj * 128 + n * 16) = xi + gv[bj][n] * acc[ai][bj][m][n]; } }
    }
};
struct EpiFfn1 {
    static constexpr bool PERM = true; bf16_t* Hd;
    __device__ __forceinline__ void operator()(const AccT& acc, const pg8::Unit& u, int wr, int wc, int fr, int fq) const {
        const int row0 = u.pm * 256 + wr * 64 + fr, col0 = u.pn * 128 + wc * 32 + 8 * fq;
#pragma unroll
        for (int ai = 0; ai < 2; ++ai)
#pragma unroll
            for (int m = 0; m < 4; ++m) { bf16_t* rowp = Hd + (size_t)(row0 + ai * 128 + m * 16) * FF + col0;
                const f32x4 a0 = acc[ai][0][m][0], a1 = acc[ai][0][m][1], b0 = acc[ai][1][m][0], b1 = acc[ai][1][m][1];
                *(u32x4*)rowp = (u32x4){pk2(siluf_(a0[0]) * b0[0], siluf_(a0[1]) * b0[1]), pk2(siluf_(a0[2]) * b0[2], siluf_(a0[3]) * b0[3]),
                                        pk2(siluf_(a1[0]) * b1[0], siluf_(a1[1]) * b1[1]), pk2(siluf_(a1[2]) * b1[2], siluf_(a1[3]) * b1[3])}; }
    }
};

#define MFMA16(a, b, c) __builtin_amdgcn_mfma_f32_16x16x32_bf16((a), (b), (c), 0, 0, 0)
__device__ __forceinline__ void ph_swa(const Frame& F, int l, bool need_ctx, int wg_first, int wg_count) {
    constexpr int PITCH = 72;
    constexpr int NQ = 2, QR = 16 * NQ;
    LAS bf16_t* KL = (LAS bf16_t*)F.lds;
    LAS bf16_t* VT = KL + 2 * 64 * PITCH;
    LAS bf16_t* PL = VT + 2 * 64 * PITCH;
    const bf16_t* P = F.P(); bf16_t* Pw = F.P();
    const float* rope = F.rope();
    const int h = F.wave, kvh = h >> 2, g = F.lane >> 4, c = F.lane & 15;
    constexpr int NLAT = MLAT / QR, NCQ = MCTX / QR;
    const int nitems = NLAT + (need_ctx ? NCQ : 0);
    const float sink = F.I(IN_SINK)[l * 8 + h];
    for (int it = F.bid - wg_first; it < nitems; it += wg_count) {
        const bool cq = it >= NLAT;
        const int b = cq ? ((it - NLAT) / (CL / QR)) : (it / (T / QR)), qb = cq ? ((it - NLAT) % (CL / QR)) : (it % (T / QR));
        const int mq0 = cq ? (MLAT + b * CL + qb * QR) : (b * T + qb * QR), tq0 = qb * QR;
        bf16x8 qf[NQ][2];
#pragma unroll
        for (int n = 0; n < NQ; ++n) {
            const int qrow = 16 * n + c; const bf16_t* qp = P + (size_t)(mq0 + qrow) * LDP + PC_SQ + h * 64;
#pragma unroll
            for (int ks = 0; ks < 2; ++ks) {
                const u32x4 own = *(const u32x4*)(qp + 32 * ks + 8 * g);
                float v[8] = {bflo(own.x), bfhi(own.x), bflo(own.y), bfhi(own.y), bflo(own.z), bfhi(own.z), bflo(own.w), bfhi(own.w)};
                if (!cq) {
                    const u32x4 pr = *(const u32x4*)(qp + 32 * ks + 8 * (g ^ 2));
                    const float pv[8] = {bflo(pr.x), bfhi(pr.x), bflo(pr.y), bfhi(pr.y), bflo(pr.z), bfhi(pr.z), bflo(pr.w), bfhi(pr.w)};
                    const int t = tq0 + qrow, pos = ks == 0 ? (t >> 6) : (t & 63);
#pragma unroll
                    for (int j = 0; j < 8; ++j) { const int f = (8 * g + j) & 15; const float cs = rope[pos * 16 + f], sn = rope[1024 + pos * 16 + f];
                        v[j] = g < 2 ? v[j] * cs - pv[j] * sn : v[j] * cs + pv[j] * sn; }
                }
                u32x4 w; w.x = pk2(v[0] * 0.125f, v[1] * 0.125f); w.y = pk2(v[2] * 0.125f, v[3] * 0.125f); w.z = pk2(v[4] * 0.125f, v[5] * 0.125f); w.w = pk2(v[6] * 0.125f, v[7] * 0.125f);
                qf[n][ks] = __builtin_bit_cast(bf16x8, w);
            }
        }
        float m_run[NQ], l_run[NQ]; f32x4 O[4][NQ];
#pragma unroll
        for (int n = 0; n < NQ; ++n) { m_run[n] = sink; l_run[n] = g == 0 ? 1.f : 0.f;
#pragma unroll
            for (int dt = 0; dt < 4; ++dt) O[dt][n] = (f32x4){0.f, 0.f, 0.f, 0.f}; }
        const int ntiles = cq ? 4 : 9;
        for (int tix = 0; tix < ntiles; ++tix) {
            const bool local = !cq && tix < 5;
            const int kt0 = local ? tq0 - 128 + 64 * tix : 0;
            if (local && (kt0 + 64 <= 0 || kt0 >= T)) continue;
            const int ctile = cq ? tix : tix - 5;
            __syncthreads();
#pragma unroll
            for (int i = 0; i < 2; ++i) {
                const int e = F.tid + NTHR * i, key = e >> 4, kv = (e >> 3) & 1, ch = e & 7;
                int tk = kt0 + key; tk = tk < 0 ? 0 : (tk >= T ? T - 1 : tk);
                const size_t mk = local ? (size_t)(b * T + tk) : (size_t)(MLAT + b * CL + 64 * ctile + key);
                const bf16_t* kp = P + mk * LDP + PC_SK + kv * 64;
                const u32x4 own = *(const u32x4*)(kp + 8 * ch);
                u32x4 w = own;
                if (local) {
                    const u32x4 pr = *(const u32x4*)(kp + 8 * (ch ^ 2));
                    float v[8] = {bflo(own.x), bfhi(own.x), bflo(own.y), bfhi(own.y), bflo(own.z), bfhi(own.z), bflo(own.w), bfhi(own.w)};
                    const float pv[8] = {bflo(pr.x), bfhi(pr.x), bflo(pr.y), bfhi(pr.y), bflo(pr.z), bfhi(pr.z), bflo(pr.w), bfhi(pr.w)};
                    const int pos = ch < 4 ? (tk >> 6) : (tk & 63), sub = ch & 3;
#pragma unroll
                    for (int j = 0; j < 8; ++j) { const int f = (8 * sub + j) & 15; const float cs = rope[pos * 16 + f], sn = rope[1024 + pos * 16 + f];
                        v[j] = sub < 2 ? v[j] * cs - pv[j] * sn : v[j] * cs + pv[j] * sn; }
                    w.x = pk2(v[0], v[1]); w.y = pk2(v[2], v[3]); w.z = pk2(v[4], v[5]); w.w = pk2(v[6], v[7]);
                }
                *(LAS u32x4*)(KL + (kv * 64 + key) * PITCH + 8 * ch) = w;
                const u32x4 vv = *(const u32x4*)(P + mk * LDP + PC_SV + kv * 64 + 8 * ch);
                LAS bf16_t* vt = VT + (kv * 64 + 8 * ch) * PITCH + key;
                vt[0 * PITCH] = (bf16_t)(vv.x & 0xffff); vt[1 * PITCH] = (bf16_t)(vv.x >> 16); vt[2 * PITCH] = (bf16_t)(vv.y & 0xffff); vt[3 * PITCH] = (bf16_t)(vv.y >> 16);
                vt[4 * PITCH] = (bf16_t)(vv.z & 0xffff); vt[5 * PITCH] = (bf16_t)(vv.z >> 16); vt[6 * PITCH] = (bf16_t)(vv.w & 0xffff); vt[7 * PITCH] = (bf16_t)(vv.w >> 16);
            }
            __syncthreads();
            f32x4 S[4][NQ];
#pragma unroll
            for (int mi = 0; mi < 4; ++mi)
#pragma unroll
                for (int n = 0; n < NQ; ++n) S[mi][n] = (f32x4){0.f, 0.f, 0.f, 0.f};
#pragma unroll
            for (int ks = 0; ks < 2; ++ks) {
#pragma unroll
                for (int mi = 0; mi < 4; ++mi) { const bf16x8 kf = *(const LAS bf16x8*)(KL + (kvh * 64 + 16 * mi + c) * PITCH + 32 * ks + 8 * g);
#pragma unroll
                    for (int n = 0; n < NQ; ++n) S[mi][n] = MFMA16(kf, qf[n][ks], S[mi][n]); }
            }
            if (local) {
#pragma unroll
                for (int mi = 0; mi < 4; ++mi)
#pragma unroll
                    for (int n = 0; n < NQ; ++n)
#pragma unroll
                        for (int r = 0; r < 4; ++r) { const int kp_ = kt0 + 16 * mi + 4 * g + r, dkq = kp_ - (tq0 + 16 * n + c);
                            if (dkq > 128 || dkq < -128 || kp_ < 0 || kp_ >= T) S[mi][n][r] = -1e30f; }
            }
#pragma unroll
            for (int n = 0; n < NQ; ++n) {
                float mx = -3.0e38f;
#pragma unroll
                for (int mi = 0; mi < 4; ++mi)
#pragma unroll
                    for (int r = 0; r < 4; ++r) mx = fmaxf(mx, S[mi][n][r]);
                mx = fmaxf(mx, __shfl_xor(mx, 16)); mx = fmaxf(mx, __shfl_xor(mx, 32));
                const float mnew = fmaxf(m_run[n], mx), alpha = __expf(m_run[n] - mnew); m_run[n] = mnew;
                float ps = 0.f;
#pragma unroll
                for (int mi = 0; mi < 4; ++mi) {
                    float p[4];
#pragma unroll
                    for (int r = 0; r < 4; ++r) { p[r] = __expf(S[mi][n][r] - mnew); ps += p[r]; }
                    *(LAS u32x2*)(PL + (h * QR + 16 * n + c) * PITCH + 16 * mi + 4 * g) = (u32x2){pk2(p[0], p[1]), pk2(p[2], p[3])};
                }
                l_run[n] = l_run[n] * alpha + ps;
#pragma unroll
                for (int dt = 0; dt < 4; ++dt) O[dt][n] = O[dt][n] * alpha;
            }
#pragma unroll
            for (int ks = 0; ks < 2; ++ks) {
                bf16x8 pf[NQ];
#pragma unroll
                for (int n = 0; n < NQ; ++n) pf[n] = *(const LAS bf16x8*)(PL + (h * QR + 16 * n + c) * PITCH + 32 * ks + 8 * g);
#pragma unroll
                for (int dt = 0; dt < 4; ++dt) { const bf16x8 vf = *(const LAS bf16x8*)(VT + (kvh * 64 + 16 * dt + c) * PITCH + 32 * ks + 8 * g);
#pragma unroll
                    for (int n = 0; n < NQ; ++n) O[dt][n] = MFMA16(vf, pf[n], O[dt][n]); }
            }
        }
#pragma unroll
        for (int n = 0; n < NQ; ++n) {
            float lt = l_run[n]; lt += __shfl_xor(lt, 16); lt += __shfl_xor(lt, 32);
            const float inv = 1.0f / lt;
            bf16_t* op = Pw + (size_t)(mq0 + 16 * n + c) * LDP + PC_YB + h * 64 + 4 * g;
#pragma unroll
            for (int dt = 0; dt < 4; ++dt) { const f32x4 o = O[dt][n] * inv; *(u32x2*)(op + 16 * dt) = (u32x2){pk2(o[0], o[1]), pk2(o[2], o[3])}; }
        }
    }
}

__device__ __forceinline__ void ph_gla(const Frame& F, int l, bool need_ctx, int wg_first, int wg_count) {
    constexpr int PITCH = 72;
    LAS bf16_t* QT = (LAS bf16_t*)F.lds;
    LAS bf16_t* KT = QT + 64 * PITCH;
    LAS bf16_t* KHT = KT + 64 * PITCH;
    LAS bf16_t* VTt = KHT + 64 * PITCH;
    LAS bf16_t* STt = VTt + 64 * PITCH;
    LAS bf16_t* ATT = STt + 64 * PITCH;
    LAS float* Gm = (LAS float*)(ATT + 64 * PITCH);
    LAS float* SEG = Gm + 64 * 65;
    LAS float* WGK = SEG + 8 * 64;
    LAS float* BGK = WGK + 16 * 64;
    const bf16_t* P = F.P(); bf16_t* Hout = F.H();
    const int g = F.lane >> 4, c = F.lane & 15, w = F.wave;
    for (int it = F.bid - wg_first; it < 64; it += wg_count) {
        const int b = it >> 4, h = (it >> 2) & 3, dir = (it >> 1) & 1, vh = it & 1;
        __syncthreads();
        for (int i = F.tid; i < 16 * 64; i += NTHR) WGK[i] = F.I(IN_WGK2)[(size_t)((l * 2 + dir) * 16 + (i >> 6)) * 256 + h * 64 + (i & 63)];
        if (F.tid < 64) BGK[F.tid] = F.I(IN_BGK)[(l * 2 + dir) * 256 + h * 64 + F.tid];
        const int vt = w >> 1, kt0 = 2 * (w & 1);
        f32x4 Sacc[2] = {(f32x4){0.f, 0.f, 0.f, 0.f}, (f32x4){0.f, 0.f, 0.f, 0.f}};
        __syncthreads();
        for (int s = 0; s < 68; ++s) {
            const bool cph = s < 4; int cidx = cph ? s : s - 4; if (dir) cidx = (cph ? 3 : 63) - cidx;
            const int m0 = cph ? MLAT + b * CL + 64 * cidx : b * T + 64 * cidx;
            const bool want_out = !cph || need_ctx;
            const int p = F.tid >> 3, k8 = F.tid & 7;
            const int tokp = m0 + (dir ? 63 - p : p);
            {
                const bf16_t* gp = P + (size_t)tokp * LDP + (dir ? PC_GKB : PC_GKF);
                const u32x4 g0 = *(const u32x4*)gp, g1 = *(const u32x4*)(gp + 8);
                const float gk[16] = {bflo(g0.x), bfhi(g0.x), bflo(g0.y), bfhi(g0.y), bflo(g0.z), bfhi(g0.z), bflo(g0.w), bfhi(g0.w),
                                      bflo(g1.x), bfhi(g1.x), bflo(g1.y), bfhi(g1.y), bflo(g1.z), bfhi(g1.z), bflo(g1.w), bfhi(g1.w)};
#pragma unroll
                for (int kk = 0; kk < 8; ++kk) { const int k = 8 * k8 + kk; float x = BGK[k];
#pragma unroll
                    for (int j = 0; j < 16; ++j) x += gk[j] * WGK[j * 64 + k];
                    Gm[p * 65 + k] = -softplusf_(-x) * (1.0f / 16.0f); }
            }
            __syncthreads();
            {
                const int k = F.tid & 63, seg = F.tid >> 6; float run = 0.f;
#pragma unroll
                for (int i = 0; i < 8; ++i) { run += Gm[(8 * seg + i) * 65 + k]; Gm[(8 * seg + i) * 65 + k] = run; }
                SEG[seg * 64 + k] = run;
                __syncthreads();
                float pre = 0.f;
                for (int s2 = 0; s2 < seg; ++s2) pre += SEG[s2 * 64 + k];
#pragma unroll
                for (int i = 0; i < 8; ++i) Gm[(8 * seg + i) * 65 + k] += pre;
            }
            __syncthreads();
            {
                const u32x4 qv = *(const u32x4*)(P + (size_t)tokp * LDP + PC_GQ + h * 64 + 8 * k8);
                const u32x4 kv = *(const u32x4*)(P + (size_t)tokp * LDP + PC_GK + h * 64 + 8 * k8);
                const u32x4 vv = *(const u32x4*)(P + (size_t)tokp * LDP + PC_GV + h * 128 + vh * 64 + 8 * k8);
                const float q[8] = {bflo(qv.x), bfhi(qv.x), bflo(qv.y), bfhi(qv.y), bflo(qv.z), bfhi(qv.z), bflo(qv.w), bfhi(qv.w)};
                const float kx[8] = {bflo(kv.x), bfhi(kv.x), bflo(kv.y), bfhi(kv.y), bflo(kv.z), bfhi(kv.z), bflo(kv.w), bfhi(kv.w)};
                float qs[8], ks_[8];
#pragma unroll
                for (int kk = 0; kk < 8; ++kk) { const float bb = Gm[p * 65 + 8 * k8 + kk], bl = Gm[63 * 65 + 8 * k8 + kk];
                    qs[kk] = q[kk] * 0.125f * __expf(bb); ks_[kk] = kx[kk] * __expf(-bb);
                    KHT[(8 * k8 + kk) * PITCH + p] = (bf16_t)f2bf(kx[kk] * __expf(bl - bb)); }
                *(LAS u32x4*)(QT + p * PITCH + 8 * k8) = (u32x4){pk2(qs[0], qs[1]), pk2(qs[2], qs[3]), pk2(qs[4], qs[5]), pk2(qs[6], qs[7])};
                *(LAS u32x4*)(KT + p * PITCH + 8 * k8) = (u32x4){pk2(ks_[0], ks_[1]), pk2(ks_[2], ks_[3]), pk2(ks_[4], ks_[5]), pk2(ks_[6], ks_[7])};
                LAS bf16_t* vtp = VTt + (8 * k8) * PITCH + p;
                vtp[0 * PITCH] = (bf16_t)(vv.x & 0xffff); vtp[1 * PITCH] = (bf16_t)(vv.x >> 16); vtp[2 * PITCH] = (bf16_t)(vv.y & 0xffff); vtp[3 * PITCH] = (bf16_t)(vv.y >> 16);
                vtp[4 * PITCH] = (bf16_t)(vv.z & 0xffff); vtp[5 * PITCH] = (bf16_t)(vv.z >> 16); vtp[6 * PITCH] = (bf16_t)(vv.w & 0xffff); vtp[7 * PITCH] = (bf16_t)(vv.w >> 16);
#pragma unroll
                for (int i = 0; i < 2; ++i)
#pragma unroll
                    for (int r = 0; r < 4; ++r) STt[(16 * vt + 4 * g + r) * PITCH + 16 * (kt0 + i) + c] = (bf16_t)f2bf(Sacc[i][r]);
            }
            __syncthreads();
            {
                const int itl = w >> 1;
#pragma unroll
                for (int jj = 0; jj < 2; ++jj) {
                    const int jt = 2 * (w & 1) + jj;
                    f32x4 a = (f32x4){0.f, 0.f, 0.f, 0.f};
                    if (jt <= itl) {
#pragma unroll
                        for (int ks = 0; ks < 2; ++ks) {
                            const bf16x8 kf = *(const LAS bf16x8*)(KT + (16 * jt + c) * PITCH + 32 * ks + 8 * g);
                            const bf16x8 qf = *(const LAS bf16x8*)(QT + (16 * itl + c) * PITCH + 32 * ks + 8 * g);
                            a = MFMA16(kf, qf, a);
                        }
#pragma unroll
                        for (int r = 0; r < 4; ++r) if (16 * jt + 4 * g + r > 16 * itl + c) a[r] = 0.f;
                    }
                    *(LAS u32x2*)(ATT + (16 * itl + c) * PITCH + 16 * jt + 4 * g) = (u32x2){pk2(a[0], a[1]), pk2(a[2], a[3])};
                }
            }
            __syncthreads();
            {
#pragma unroll
                for (int ii = 0; ii < 2; ++ii) {
                    const int itl = 2 * (w & 1) + ii;
                    f32x4 o = (f32x4){0.f, 0.f, 0.f, 0.f};
#pragma unroll
                    for (int ks = 0; ks < 2; ++ks) {
                        const bf16x8 sf = *(const LAS bf16x8*)(STt + (16 * vt + c) * PITCH + 32 * ks + 8 * g);
                        const bf16x8 qf = *(const LAS bf16x8*)(QT + (16 * itl + c) * PITCH + 32 * ks + 8 * g);
                        o = MFMA16(sf, qf, o);
                        const bf16x8 vf = *(const LAS bf16x8*)(VTt + (16 * vt + c) * PITCH + 32 * ks + 8 * g);
                        const bf16x8 af = *(const LAS bf16x8*)(ATT + (16 * itl + c) * PITCH + 32 * ks + 8 * g);
                        o = MFMA16(vf, af, o);
                    }
                    if (want_out) { const int pi = 16 * itl + c; const int tok = m0 + (dir ? 63 - pi : pi);
                        *(u32x2*)(Hout + (size_t)tok * D + dir * 512 + h * 128 + vh * 64 + 16 * vt + 4 * g) = (u32x2){pk2(o[0], o[1]), pk2(o[2], o[3])}; }
                }
#pragma unroll
                for (int i = 0; i < 2; ++i) {
                    const int kt = kt0 + i; const float dec = __expf(Gm[63 * 65 + 16 * kt + c]);
                    f32x4 sn = Sacc[i] * dec;
#pragma unroll
                    for (int ts = 0; ts < 2; ++ts) {
                        const bf16x8 vf = *(const LAS bf16x8*)(VTt + (16 * vt + c) * PITCH + 32 * ts + 8 * g);
                        const bf16x8 kf = *(const LAS bf16x8*)(KHT + (16 * kt + c) * PITCH + 32 * ts + 8 * g);
                        sn = MFMA16(vf, kf, sn);
                    }
                    Sacc[i] = sn;
                }
            }
            __syncthreads();
        }
    }
}

__device__ __forceinline__ void ph_rwkv_scan(const Frame& F, int l, bool need_ctx, int wg_first, int wg_count) {
    constexpr int TB = 32;
    LAS float* Ww = (LAS float*)F.lds;
    LAS float* Wa = Ww + 64 * 64;
    LAS float* XR = Wa + 64 * 64;
    LAS float* XK = XR + TB * 64;
    LAS float* XV = XK + TB * 64;
    LAS float* XW = XV + TB * 64;
    LAS float* XA = XW + TB * 64;
    LAS float* FKK = XA + TB * 64;
    LAS float* FRT = FKK + TB * 64;
    LAS float* FW = FRT + TB * 64;
    LAS float* FNA = FW + TB * 64;
    LAS float* FKM = FNA + TB * 64;
    LAS float* FC = FKM + TB * 64;
    LAS float* YB = FC + TB;
    const bf16_t* P = F.P(); bf16_t* Yout = F.Fb(); float* Cout = F.Cb();
    const float* mu = F.I(IN_MU) + l * 1792;
    for (int it = F.bid - wg_first; it < 128; it += wg_count) {
        const int b = it >> 5, h = (it >> 2) & 7, dir = (it >> 1) & 1, rh = it & 1;
        __syncthreads();
        for (int i = F.tid; i < 64 * 64; i += NTHR) { const int j = i >> 6, k = i & 63;
            Ww[i] = F.I(IN_WW2)[(size_t)((l * 2 + dir) * 64 + j) * 512 + h * 64 + k];
            Wa[i] = F.I(IN_WA2)[(size_t)((l * 2 + dir) * 64 + j) * 512 + h * 64 + k]; }
        const int kq = F.lane & 15, rowl = F.wave * 4 + (F.lane >> 4);
        const int p_ = F.tid >> 4, c4 = F.tid & 15;
        f32x4 st = (f32x4){0.f, 0.f, 0.f, 0.f};
        float w0v[4], a0v[4], kkv[4], kav[4], rkv[4], mur[4], muk[4], muv[4], muw[4], mua[4];
#pragma unroll
        for (int j = 0; j < 4; ++j) { const int ch = h * 64 + 4 * c4 + j;
            w0v[j] = F.I(IN_W0)[(l * 2 + dir) * 512 + ch]; a0v[j] = F.I(IN_A0)[(l * 2 + dir) * 512 + ch];
            kkv[j] = F.I(IN_KK)[l * 512 + ch]; kav[j] = F.I(IN_KA)[l * 512 + ch]; rkv[j] = F.I(IN_RK)[l * 512 + ch];
            mur[j] = mu[ch]; muk[j] = mu[512 + ch]; muv[j] = mu[1024 + ch]; muw[j] = mu[1536 + 4 * c4 + j]; mua[j] = mu[1600 + 4 * c4 + j]; }
        for (int blk = 0; blk < 4352 / TB; ++blk) {
            const bool cph = blk < CL / TB; int bi = cph ? blk : blk - CL / TB; if (dir) bi = (cph ? CL / TB - 1 : T / TB - 1) - bi;
            const int slen = cph ? CL : T, sbase = cph ? MLAT + b * CL : b * T, t0 = bi * TB;
            const bool want_out = !cph || need_ctx;
            __syncthreads();
            {
                const int t = t0 + (dir ? TB - 1 - p_ : p_);
                const bf16_t* rowc = P + (size_t)(sbase + t) * LDP;
                const bool hp = t > 0, hn = t < slen - 1;
                const bf16_t* rowp = hp ? rowc - LDP : rowc; const bf16_t* rown = hn ? rowc + LDP : rowc;
                const float fp = hp ? 0.5f : 0.f, fn = hn ? 0.5f : 0.f;
#define RW_MIX(col, muarr, DST, TANH) { const u32x2 xc = *(const u32x2*)(rowc + (col)), xp = *(const u32x2*)(rowp + (col)), xn = *(const u32x2*)(rown + (col)); \
                    const float cc[4] = {bflo(xc.x), bfhi(xc.x), bflo(xc.y), bfhi(xc.y)}, pp[4] = {bflo(xp.x), bfhi(xp.x), bflo(xp.y), bfhi(xp.y)}, nn[4] = {bflo(xn.x), bfhi(xn.x), bflo(xn.y), bfhi(xn.y)}; \
                    f32x4 o; _Pragma("unroll") for (int j = 0; j < 4; ++j) { float vv = cc[j] + muarr[j] * ((fp * pp[j] + fn * nn[j]) - cc[j]); o[j] = TANH ? tanhf(vv) : vv; } \
                    *(LAS f32x4*)(DST + p_ * 64 + 4 * c4) = o; }
                RW_MIX(PC_RR + h * 64 + 4 * c4, mur, XR, false)
                RW_MIX(PC_RK + h * 64 + 4 * c4, muk, XK, false)
                RW_MIX(PC_RV + h * 64 + 4 * c4, muv, XV, false)
                RW_MIX(PC_WL + 4 * c4, muw, XW, true)
                RW_MIX(PC_AL + 4 * c4, mua, XA, false)
#undef RW_MIX
            }
            __syncthreads();
            {
                f32x4 dw = (f32x4){0.f, 0.f, 0.f, 0.f}, da = (f32x4){0.f, 0.f, 0.f, 0.f};
#pragma unroll 8
                for (int j = 0; j < 64; ++j) { const float xw = XW[p_ * 64 + j], xa = XA[p_ * 64 + j];
                    dw += *(const LAS f32x4*)(Ww + j * 64 + 4 * c4) * xw; da += *(const LAS f32x4*)(Wa + j * 64 + 4 * c4) * xa; }
                const f32x4 r4 = *(const LAS f32x4*)(XR + p_ * 64 + 4 * c4), k4 = *(const LAS f32x4*)(XK + p_ * 64 + 4 * c4);
                f32x4 wd, av, kkr, km;
                float ss = 0.f;
#pragma unroll
                for (int j = 0; j < 4; ++j) {
                    const float wraw = -softplusf_(-(w0v[j] + dw[j])) - 0.5f;
                    wd[j] = __expf(-__expf(wraw));
                    av[j] = sigmoidf_(a0v[j] + da[j]);
                    kkr[j] = k4[j] * kkv[j]; ss += kkr[j] * kkr[j];
                    km[j] = k4[j] * (1.0f + (av[j] - 1.0f) * kav[j]);
                }
                ss = sum16(ss);
                const float rn = 1.0f / fmaxf(sqrtf(ss), 1e-12f);
                f32x4 kk4, kka;
                float d1 = 0.f, cdot = 0.f, bon = 0.f;
#pragma unroll
                for (int j = 0; j < 4; ++j) { kk4[j] = kkr[j] * rn; kka[j] = kk4[j] * av[j]; d1 += kka[j] * r4[j]; cdot += km[j] * r4[j]; bon += r4[j] * km[j] * rkv[j]; }
                d1 = sum16(d1); cdot = sum16(cdot); bon = sum16(bon);
                f32x4 rt;
#pragma unroll
                for (int j = 0; j < 4; ++j) rt[j] = wd[j] * r4[j] - kk4[j] * d1;
                *(LAS f32x4*)(FKK + p_ * 64 + 4 * c4) = kk4; *(LAS f32x4*)(FRT + p_ * 64 + 4 * c4) = rt; *(LAS f32x4*)(FW + p_ * 64 + 4 * c4) = wd;
                *(LAS f32x4*)(FNA + p_ * 64 + 4 * c4) = -kka; *(LAS f32x4*)(FKM + p_ * 64 + 4 * c4) = km;
                if (c4 == 0) { FC[p_] = cdot;
                    if (rh == 0 && want_out) { const int t = t0 + (dir ? TB - 1 - p_ : p_); Cout[(size_t)(sbase + t) * 16 + h * 2 + dir] = bon; } }
            }
            __syncthreads();
#pragma unroll 4
            for (int p = 0; p < TB; ++p) {
                const f32x4 kk4 = *(const LAS f32x4*)(FKK + p * 64 + 4 * kq), rt4 = *(const LAS f32x4*)(FRT + p * 64 + 4 * kq), w4 = *(const LAS f32x4*)(FW + p * 64 + 4 * kq),
                            na4 = *(const LAS f32x4*)(FNA + p * 64 + 4 * kq), km4 = *(const LAS f32x4*)(FKM + p * 64 + 4 * kq);
                const float vv = XV[p * 64 + rh * 32 + rowl], cc = FC[p];
                float sa = (st[0] * kk4[0] + st[1] * kk4[1]) + (st[2] * kk4[2] + st[3] * kk4[3]);
                float yy = (st[0] * rt4[0] + st[1] * rt4[1]) + (st[2] * rt4[2] + st[3] * rt4[3]);
                sa = sum16(sa); yy = sum16(yy);
                st = st * w4 + na4 * sa + km4 * vv;
                if (kq == 0) YB[p * 32 + rowl] = yy + vv * cc;
            }
            __syncthreads();
            if (want_out) {
                const int pp = F.tid >> 4, r2 = (F.tid & 15) * 2;
                const int t = t0 + (dir ? TB - 1 - pp : pp);
                *(unsigned*)(Yout + (size_t)(sbase + t) * D + dir * 512 + h * 64 + rh * 32 + r2) = pk2(YB[pp * 32 + r2], YB[pp * 32 + r2 + 1]);
            }
        }
    }
}

__device__ __forceinline__ void ph_finalize(const Frame& F, int l, int nrows, const float* xlat, const float* xctx) {
    const int per = nrows / F.G;
    const int mlo = F.bid * per, mhi = mlo + per;
    bf16_t* P = F.P(); bf16_t* Hb = F.H();
    {
        const int hh = F.wave & 3; const float g0 = F.I(IN_GGLA)[l * 128 + 2 * F.lane], g1 = F.I(IN_GGLA)[l * 128 + 2 * F.lane + 1];
        for (int m = mlo + (F.wave >> 2); m < mhi; m += 2) {
            const unsigned uf = *(const unsigned*)(Hb + (size_t)m * D + hh * 128 + 2 * F.lane), ub = *(const unsigned*)(Hb + (size_t)m * D + 512 + hh * 128 + 2 * F.lane);
            const float o0 = bflo(uf) + bflo(ub), o1 = bfhi(uf) + bfhi(ub);
            const float rstd = 1.0f / sqrtf(wave_sum(o0 * o0 + o1 * o1) * (1.0f / 128.0f) + 1e-6f);
            unsigned* ogp = (unsigned*)(P + (size_t)m * LDP + PC_OG + hh * 128 + 2 * F.lane);
            const unsigned uo = *ogp;
            *ogp = pk2(o0 * rstd * g0 * siluf_(bflo(uo)), o1 * rstd * g1 * siluf_(bfhi(uo)));
        }
    }
    __syncthreads();
    {
        const float* g = F.I(IN_GMIX) + l * D;
        for (int m = mlo + F.wave; m < mhi; m += NWAVES) {
            const float* src = m < MLAT ? xlat + (size_t)m * D : xctx + (size_t)(m - MLAT) * D;
            const int mr = m < MLAT ? (m >> 12) : 4;
            const float* md = F.mod() + (size_t)(l * 5 + mr) * 6144;
            prep_row(F, src, g, md, md + D, Hb + (size_t)m * D);
        }
    }
    {
        LAS float* SGT = (LAS float*)F.lds;
        const int ch = F.tid, hh = ch >> 6;
        const float* wg2 = F.I(IN_WG2) + (size_t)l * 128 * 512 + ch;
        const float gw_ = F.I(IN_GNW)[l * 512 + ch], gb_ = F.I(IN_GNB)[l * 512 + ch];
        const float* mu = F.I(IN_MU) + l * 1792;
        const float muv = mu[1024 + ch];
        const int tt = F.tid >> 5, j4 = (F.tid & 31) * 4;
        const float mug[4] = {mu[1664 + j4], mu[1664 + j4 + 1], mu[1664 + j4 + 2], mu[1664 + j4 + 3]};
        const bf16_t* Yin = F.Fb(); const float* Cin = F.Cb();
        for (int mb = mlo; mb < mhi; mb += 16) {
            const int ns = (mhi - mb) < 16 ? (mhi - mb) : 16;
            __syncthreads();
            {
                f32x4 o = (f32x4){0.f, 0.f, 0.f, 0.f};
                if (tt < ns) {
                    const int m = mb + tt; const bool lat = m < MLAT; const int t = lat ? (m & (T - 1)) : ((m - MLAT) & (CL - 1)), slen = lat ? T : CL;
                    const bf16_t* rowc = P + (size_t)m * LDP + PC_GL + j4;
                    const bool hp = t > 0, hn = t < slen - 1;
                    const u32x2 xc = *(const u32x2*)rowc, xp = *(const u32x2*)(hp ? rowc - LDP : rowc), xn = *(const u32x2*)(hn ? rowc + LDP : rowc);
                    const float fp = hp ? 0.5f : 0.f, fn = hn ? 0.5f : 0.f;
                    const float cc[4] = {bflo(xc.x), bfhi(xc.x), bflo(xc.y), bfhi(xc.y)}, pp[4] = {bflo(xp.x), bfhi(xp.x), bflo(xp.y), bfhi(xp.y)}, nn[4] = {bflo(xn.x), bfhi(xn.x), bflo(xn.y), bfhi(xn.y)};
#pragma unroll
                    for (int j = 0; j < 4; ++j) o[j] = sigmoidf_(cc[j] + mug[j] * ((fp * pp[j] + fn * nn[j]) - cc[j]));
                }
#pragma unroll
                for (int j = 0; j < 4; ++j) SGT[(j4 + j) * 16 + tt] = o[j];
            }
            __syncthreads();
            float gacc[16];
#pragma unroll
            for (int ti = 0; ti < 16; ++ti) gacc[ti] = 0.f;
#pragma unroll 4
            for (int j = 0; j < 128; ++j) {
                const float wv = wg2[(size_t)j * 512];
                const f32x4 s0 = *(const LAS f32x4*)(SGT + j * 16), s1 = *(const LAS f32x4*)(SGT + j * 16 + 4), s2 = *(const LAS f32x4*)(SGT + j * 16 + 8), s3 = *(const LAS f32x4*)(SGT + j * 16 + 12);
#pragma unroll
                for (int q = 0; q < 4; ++q) { gacc[q] += s0[q] * wv; gacc[4 + q] += s1[q] * wv; gacc[8 + q] += s2[q] * wv; gacc[12 + q] += s3[q] * wv; }
            }
#pragma unroll
            for (int ti = 0; ti < 16; ++ti) {
                if (ti < ns) {
                    const int m = mb + ti; const bool lat = m < MLAT; const int t = lat ? (m & (T - 1)) : ((m - MLAT) & (CL - 1)), slen = lat ? T : CL;
                    const float y = bf2f(Yin[(size_t)m * D + ch]) + bf2f(Yin[(size_t)m * D + 512 + ch]);
                    const float mean = wave_sum(y) * (1.0f / 64.0f); const float dv = y - mean;
                    const float var = wave_sum(dv * dv) * (1.0f / 64.0f);
                    const float yn = dv * (1.0f / sqrtf(var + 64e-5f)) * gw_ + gb_;
                    const bf16_t* vc = P + (size_t)m * LDP + PC_RV + ch;
                    const bool hp = t > 0, hn = t < slen - 1;
                    const float vcur = bf2f(vc[0]), vprev = hp ? bf2f(vc[-LDP]) : 0.f, vnext = hn ? bf2f(vc[LDP]) : 0.f;
                    const float vmix = vcur + muv * (0.5f * (vprev + vnext) - vcur);
                    const float bon = Cin[(size_t)m * 16 + hh * 2] + Cin[(size_t)m * 16 + hh * 2 + 1];
                    P[(size_t)m * LDP + PC_YC + ch] = (bf16_t)f2bf((yn + bon * vmix) * gacc[ti]);
                }
            }
        }
    }
}

__device__ __forceinline__ void ph_msum(const Frame& F, int nrows) {
    const bf16_t* P = F.P(); const bf16_t* Fb = F.Fb(); bf16_t* Hb = F.H();
    const size_t total = (size_t)nrows * 128;
    for (size_t i = (size_t)F.bid * NTHR + F.tid; i < total; i += (size_t)F.G * NTHR) {
        const size_t m = i >> 7; const int c8 = (int)(i & 127) * 8;
        const u32x4 a = *(const u32x4*)(P + m * LDP + PC_B0 + c8), b = *(const u32x4*)(P + m * LDP + PC_B1 + c8), c = *(const u32x4*)(Fb + m * D + c8);
        u32x4 o;
        o.x = pk2(bflo(a.x) + bflo(b.x) + bflo(c.x), bfhi(a.x) + bfhi(b.x) + bfhi(c.x)); o.y = pk2(bflo(a.y) + bflo(b.y) + bflo(c.y), bfhi(a.y) + bfhi(b.y) + bfhi(c.y));
        o.z = pk2(bflo(a.z) + bflo(b.z) + bflo(c.z), bfhi(a.z) + bfhi(b.z) + bfhi(c.z)); o.w = pk2(bflo(a.w) + bflo(b.w) + bflo(c.w), bfhi(a.w) + bfhi(b.w) + bfhi(c.w));
        *(u32x4*)(Hb + m * D + c8) = o;
    }
}

__device__ __forceinline__ void ph_final_norm(const Frame& F) {
    const int gw = F.bid * NWAVES + F.wave, NGW = F.G * NWAVES;
    const float* g = F.I(IN_GFIN);
    for (int m = gw; m < MLAT; m += NGW) {
        f32x4* xr = (f32x4*)(F.out + (size_t)m * D) + F.lane;
        f32x4 v[4]; float s = 0.f;
#pragma unroll
        for (int j = 0; j < 4; ++j) { v[j] = xr[64 * j]; s += (v[j].x * v[j].x + v[j].y * v[j].y) + (v[j].z * v[j].z + v[j].w * v[j].w); }
        const float rstd = 1.0f / sqrtf(wave_sum(s) * (1.0f / D) + 1e-6f);
#pragma unroll
        for (int j = 0; j < 4; ++j) xr[64 * j] = v[j] * rstd * ((const f32x4*)g)[F.lane + 64 * j];
    }
}

constexpr int NPHASE = 24;
template <int MODE> __global__ void __launch_bounds__(NTHR, 2) fwd_kernel(KArgs args) {
    extern __shared__ __attribute__((aligned(16))) unsigned char lds_raw[];
    Frame F;
    F.lds = (LAS unsigned char*)lds_raw;
    F.tid = threadIdx.x; F.lane = F.tid & 63; F.wave = __builtin_amdgcn_readfirstlane(F.tid >> 6);
    F.G = gridDim.x; F.bid = blockIdx.x; F.in = args.in; F.out = args.out; F.ws = args.ws;
    const int lo = args.ph_lo, hi = args.ph_hi;
#if MK_SINGLE
    volatile LAS unsigned* misc = (volatile LAS unsigned*)(F.lds + LDS_MISC);
    if (F.tid < 4) misc[F.tid] = 0u;
    __syncthreads();
    XcdBarrier bar = xcd_barrier_post((unsigned*)(F.ws + WS_CTL) + CW_BAR, misc);
#define GRID_BAR() xcd_barrier(bar)
#else
#define GRID_BAR() do {} while (0)
#endif
#define IN(k) (lo <= (k) && (k) < hi)
#define CLS(c) (MODE < 0 || MODE == (c))
#define SEAM(k) do { if (IN(k) && IN((k) + 1)) GRID_BAR(); } while (0)
    const float* x_in = F.I(IN_X); const float* c_in = F.I(IN_CTX);
    if constexpr (CLS(0)) if (IN(0)) { ph_mods(F); ph_convert_weights(F, 0); }
    SEAM(0);
    for (int l = 0; l < DEPTH; ++l) {
        const int pb = 1 + 11 * l;
        const bool need_ctx = l < DEPTH - 1;
        const float* xl = l == 0 ? x_in : F.out; const float* xc = l == 0 ? c_in : F.Z();
        const int nrows2 = need_ctx ? MTOT : MLAT;
        const int npan2 = nrows2 / 256;
        const float* modl = F.mod() + (size_t)l * 5 * 6144;
        if constexpr (CLS(1)) if (IN(pb + 0)) { if (l > 0) ph_convert_weights(F, l); ph_prep_h(F, l, 0, MTOT, xl, xc); }
        SEAM(pb + 0);
        if constexpr (CLS(2)) if (IN(pb + 1)) {
            SchedPlain S; S.o.init(MTOT / 256, NPW / 256, F.G, F.bid); S.A = (const char*)F.H(); S.B = (const char*)F.W(WO_IN); S.tA = (size_t)256 * D * 2; S.tB = (size_t)256 * D * 2;
            EpiStoreP E{F.P()};
            pg8::gemm_phase(F.lds, pg8::Dims{D, D, D}, S, E);
        }
        SEAM(pb + 1);
        if constexpr (CLS(3)) if (IN(pb + 2)) {
            if (F.G >= 256) {
                if (F.bid < 128) ph_rwkv_scan(F, l, need_ctx, 0, 128);
                else if (F.bid < 192) ph_gla(F, l, need_ctx, 128, 64);
                else ph_swa(F, l, need_ctx, 192, F.G - 192);
            } else { ph_rwkv_scan(F, l, need_ctx, 0, F.G); ph_gla(F, l, need_ctx, 0, F.G); ph_swa(F, l, need_ctx, 0, F.G); }
        }
        SEAM(pb + 2);
        if constexpr (CLS(4)) if (IN(pb + 3)) ph_finalize(F, l, nrows2, xl, xc);
        SEAM(pb + 3);
        BranchDst bd; bd.pb = F.P(); bd.fb = F.Fb();
        if constexpr (CLS(5)) if (IN(pb + 4)) {
            SchedBranch S; S.o.init(npan2, 12, F.G, F.bid); S.Pb = (const char*)F.P(); S.Wb = (const char*)F.W(WO_B);
            EpiBranch E{bd};
            pg8::gemm_phase(F.lds, pg8::Dims{512, LDP, 512}, S, E);
        }
        SEAM(pb + 4);
        if constexpr (CLS(6)) if (IN(pb + 5)) {
            SchedPlain S; S.o.init(npan2, 12, F.G, F.bid); S.A = (const char*)F.H(); S.B = (const char*)F.W(WO_G); S.tA = (size_t)256 * D * 2; S.tB = (size_t)256 * D * 2;
            EpiGate E{bd};
            pg8::gemm_phase(F.lds, pg8::Dims{D, D, D}, S, E);
        }
        SEAM(pb + 5);
        if constexpr (CLS(7)) if (IN(pb + 6)) ph_msum(F, nrows2);
        SEAM(pb + 6);
        if constexpr (CLS(8)) if (IN(pb + 7)) {
            SchedPlain S; S.o.init(npan2, 4, F.G, F.bid); S.A = (const char*)F.H(); S.B = (const char*)F.W(WO_O); S.tA = (size_t)256 * D * 2; S.tB = (size_t)256 * D * 2;
            EpiRes E{xl, xc, F.out, F.Z(), modl, 2 * D};
            pg8::gemm_phase(F.lds, pg8::Dims{D, D, D}, S, E);
        }
        SEAM(pb + 7);
        if constexpr (CLS(1)) if (IN(pb + 8)) ph_prep_h(F, l, 1, nrows2, F.out, F.Z());
        SEAM(pb + 8);
        if constexpr (CLS(9)) if (IN(pb + 9)) {
            SchedPlain S; S.o.init(npan2, 2 * FF / 256, F.G, F.bid); S.A = (const char*)F.H(); S.B = (const char*)F.W(WO_13); S.tA = (size_t)256 * D * 2; S.tB = (size_t)256 * D * 2;
            EpiFfn1 E{F.P()};
            pg8::gemm_phase(F.lds, pg8::Dims{D, D, D}, S, E);
        }
        SEAM(pb + 9);
        if constexpr (CLS(8)) if (IN(pb + 10)) {
            SchedPlain S; S.o.init(npan2, 4, F.G, F.bid); S.A = (const char*)F.P(); S.B = (const char*)F.W(WO_2); S.tA = (size_t)256 * FF * 2; S.tB = (size_t)256 * FF * 2;
            EpiRes E{F.out, F.Z(), F.out, F.Z(), modl, 5 * D};
            pg8::gemm_phase(F.lds, pg8::Dims{FF, FF, FF}, S, E);
        }
        SEAM(pb + 10);
    }
    if constexpr (CLS(10)) if (IN(NPHASE - 1)) ph_final_norm(F);
#undef IN
#undef CLS
#undef SEAM
#undef GRID_BAR
}

static int phase_class(int p) {
    if (p == 0) return 0; if (p == NPHASE - 1) return 10;
    static const int cls[11] = {1, 2, 3, 4, 5, 6, 7, 8, 1, 9, 8};
    return cls[(p - 1) % 11];
}
template <int C> static bool set_lds_attr() { return hipFuncSetAttribute((const void*)fwd_kernel<C>, hipFuncAttributeMaxDynamicSharedMemorySize, LDS_BYTES) == hipSuccess; }
extern "C" void kernel_launch(void* const* d_in, const int* in_sizes, int n_in, void* d_out, int out_size, void* d_ws, size_t ws_size, hipStream_t stream) {
    static int grid = 0;
    if (grid == 0) {
        if (n_in != 30 || out_size != MLAT * D || ws_size < WS_END) { fprintf(stderr, "kernel_launch: unexpected problem (n_in %d, out %d, ws %zu < %zu)\n", n_in, out_size, ws_size, (size_t)WS_END); grid = -1; return; }
        int dev = 0, cus = 0, per_cu = 0;
        if (hipGetDevice(&dev) != hipSuccess || hipDeviceGetAttribute(&cus, hipDeviceAttributeMultiprocessorCount, dev) != hipSuccess) { grid = -1; return; }
#if MK_SINGLE
        if (!set_lds_attr<-1>()) { fprintf(stderr, "kernel_launch: hipFuncSetAttribute failed\n"); grid = -1; return; }
        if (hipOccupancyMaxActiveBlocksPerMultiprocessor(&per_cu, (const void*)fwd_kernel<-1>, NTHR, LDS_BYTES) != hipSuccess || per_cu < 1) { fprintf(stderr, "kernel_launch: occupancy query says %d\n", per_cu); per_cu = 1; }
#else
        if (!(set_lds_attr<0>() && set_lds_attr<1>() && set_lds_attr<2>() && set_lds_attr<3>() && set_lds_attr<4>() && set_lds_attr<5>() && set_lds_attr<6>() && set_lds_attr<7>() && set_lds_attr<8>() && set_lds_attr<9>() && set_lds_attr<10>())) { fprintf(stderr, "kernel_launch: hipFuncSetAttribute failed\n"); grid = -1; return; }
        per_cu = 1;
#endif
        (void)hipGetLastError();
        grid = cus;
        if (grid > 256) grid = 256;
    }
    if (grid < 0) return;
    KArgs a{};
    for (int i = 0; i < 30; ++i) a.in[i] = (const float*)d_in[i];
    a.out = (float*)d_out; a.ws = (unsigned char*)d_ws;
#if MK_SINGLE
    (void)hipMemsetAsync((char*)d_ws + WS_CTL, 0, CTL_ZERO_BYTES, stream);
    a.ph_lo = 0; a.ph_hi = NPHASE;
    void* kargs[] = {&a};
    hipError_t e = hipLaunchCooperativeKernel((const void*)fwd_kernel<-1>, dim3(grid), dim3(NTHR), kargs, LDS_BYTES, stream);
    if (e != hipSuccess) fprintf(stderr, "kernel_launch: cooperative launch failed: %s\n", hipGetErrorString(e));
#else
    for (int p = 0; p < NPHASE; ++p) { a.ph_lo = p; a.ph_hi = p + 1; const int cls = phase_class(p);
        switch (cls) {
#define LCASE(c) case c: hipLaunchKernelGGL(fwd_kernel<c>, dim3(grid), dim3(NTHR), LDS_BYTES, stream, a); break;
            LCASE(0) LCASE(1) LCASE(2) LCASE(3) LCASE(4) LCASE(5) LCASE(6) LCASE(7) LCASE(8) LCASE(9) LCASE(10)
#undef LCASE
        } }
#endif
}
```
